# Optimizing an MI355X kernel written in HIP

```python
import jax
import jax.numpy as jnp
from jax import lax
import numpy as np

D_MODEL = 2048
BATCH = 4
SEQ = 2048
DEPTH = 4

PLE_DIM = 256
D_FF = 5632
RMS_EPS = 1e-6
N_EVEN = (DEPTH + 1) // 2
N_ODD = DEPTH // 2
N_VRES = max(N_ODD - 1, 0)

A_WIDTH = D_MODEL // 2
A_GROUP = 128
A_GROUPS = A_WIDTH // A_GROUP
A_CHUNK = 128
B_WIDTH = D_MODEL // 2
B_HEAD_DIM = 128
B_HEADS = B_WIDTH // B_HEAD_DIM
B_CHUNK = 64
B_MIN_F = 1e-30
EVEN_IN = 2 * A_WIDTH + 4 * B_WIDTH
C_HEAD = 64
C_HEADS = D_MODEL // C_HEAD
C_DECAY_LORA = 96
C_AAA_LORA = 96
C_MV_LORA = 64
C_GATE_LORA = 256
C_GN_EPS = 64e-5

kernel_name = 'hybrid_gmlp_hgrn2_rwkv7_macaron'


def rmsnorm(x, g, eps=RMS_EPS):
    xf = x.astype(jnp.float32)
    y = xf * lax.rsqrt(jnp.mean(xf * xf, axis=-1, keepdims=True) + eps)
    return (y * g.astype(jnp.float32)).astype(x.dtype)


def swiglu(x, w_gate, w_up, w_down):
    return (jax.nn.silu(x @ w_gate) * (x @ w_up)) @ w_down


def chunked_gmlp(u, v, v_gain, w_s, b_s):
    bsz, seq, _ = u.shape
    n_chunks = seq // A_CHUNK
    vg = rmsnorm(v.reshape(bsz, seq, A_GROUPS, A_GROUP), v_gain.reshape(A_GROUPS, A_GROUP))
    vg = vg.reshape(bsz, n_chunks, A_CHUNK, A_GROUPS, A_GROUP)
    causal = jnp.tril(jnp.ones((A_CHUNK, A_CHUNK), dtype=bool))
    w = jnp.where(causal[None], w_s, jnp.zeros_like(w_s))
    s = jnp.einsum('gts,bnsgc->bntgc', w, vg) + b_s.T[None, None, :, :, None]
    return u * s.reshape(bsz, seq, A_WIDTH)


def hgrn2(q, f_logit, i_in, lb):
    bsz, seq, _ = q.shape
    n_chunks = seq // B_CHUNK
    z = f_logit.astype(jnp.float32)
    lb = lb.astype(jnp.float32)
    sig = jax.nn.sigmoid(z)
    f = lb + (1.0 - lb) * sig
    log_f = jnp.log(jnp.maximum(f, B_MIN_F))
    k = 1.0 - f
    qf = jax.nn.silu(q.astype(jnp.float32))

    def to_chunks(t):
        return t.reshape(bsz, n_chunks, B_CHUNK, B_HEADS, B_HEAD_DIM).transpose(1, 0, 3, 2, 4)

    xs = (to_chunks(qf), to_chunks(k), to_chunks(i_in.astype(jnp.float32)), to_chunks(log_f))
    causal = jnp.tril(jnp.ones((B_CHUNK, B_CHUNK), dtype=bool))[:, :, None]

    def step(state, chunk):
        qb, kb, vb, gb = chunk
        cum = jnp.cumsum(gb, axis=2)
        last = cum[:, :, -1:, :]
        o_inter = jnp.einsum('bhtk,bhkv->bhtv', qb * jnp.exp(cum), state)
        rel = cum[:, :, :, None, :] - cum[:, :, None, :, :]
        dec = jnp.where(causal, jnp.exp(jnp.minimum(rel, 0.0)), 0.0)
        att = jnp.einsum('bhtk,bhsk,bhtsk->bhts', qb, kb, dec)
        o = o_inter + jnp.einsum('bhts,bhsv->bhtv', att, vb)
        new_state = jnp.exp(last[:, :, 0, :])[..., None] * state + jnp.einsum('bhsk,bhsv->bhkv', kb * jnp.exp(last - cum), vb)
        return new_state, o

    s0 = jnp.zeros((bsz, B_HEADS, B_HEAD_DIM, B_HEAD_DIM), jnp.float32)
    _, o = lax.scan(step, s0, xs)
    return o.transpose(1, 0, 3, 2, 4).reshape(bsz, seq, B_WIDTH)


def rwkv7(x, mix, w_r, w_k, w_v, w_o, w0, w1, w2, a0, a1, a2, g1, g2, k_k, k_a, r_k, gn_g, gn_b, v_first, v_res):
    bsz, seq, d = x.shape
    xx = jnp.pad(x, ((0, 0), (1, 0), (0, 0)))[:, :-1] - x
    xr, xw, xk, xv, xa, xg = [x + xx * mix[j] for j in range(6)]
    r = xr @ w_r
    k = xk @ w_k
    v = xv @ w_v
    w = -jax.nn.softplus(-(w0 + jnp.tanh(xw @ w1) @ w2)) - 0.5
    if v_res is None:
        v_first = v
    else:
        v0, v1, v2 = v_res
        v = v + (v_first - v) * jax.nn.sigmoid(v0 + (xv @ v1) @ v2)
    a = jax.nn.sigmoid(a0 + (xa @ a1) @ a2)
    g = jax.nn.sigmoid(xg @ g1) @ g2

    def heads(t):
        return t.reshape(bsz, seq, C_HEADS, C_HEAD).astype(jnp.float32)

    kk = heads(k * k_k)
    kk = kk / jnp.maximum(jnp.sqrt(jnp.sum(kk * kk, axis=-1, keepdims=True)), 1e-12)
    k = k * (1 + (a - 1) * k_a)
    decay = jnp.exp(-jnp.exp(w.astype(jnp.float32)))
    rh, kh, vh, ah = heads(r), heads(k), heads(v), heads(a)

    def step(state, inp):
        r_t, w_t, k_t, v_t, a_t, b_t = inp
        sa = jnp.einsum('bhvk,bhk->bhv', state, a_t)
        state = state * w_t[:, :, None, :] + v_t[..., None] * k_t[:, :, None, :] + sa[..., None] * b_t[:, :, None, :]
        return state, jnp.einsum('bhvk,bhk->bhv', state, r_t)

    def time_major(t):
        return jnp.moveaxis(t, 1, 0)

    xs = tuple(time_major(t) for t in (rh, heads(decay), kh, vh, -kk, kk * ah))
    s0 = jnp.zeros((bsz, C_HEADS, C_HEAD, C_HEAD), jnp.float32)
    _, y = lax.scan(step, s0, xs)
    y = jnp.moveaxis(y, 0, 1)
    mu = jnp.mean(y, axis=-1, keepdims=True)
    var = jnp.mean(jnp.square(y - mu), axis=-1, keepdims=True)
    y = ((y - mu) * lax.rsqrt(var + C_GN_EPS)).reshape(bsz, seq, d) * gn_g + gn_b
    bonus = jnp.sum(rh * kh * r_k, axis=-1, keepdims=True) * vh
    y = (y + bonus.reshape(bsz, seq, d)).astype(x.dtype)
    return ((y * g) @ w_o).astype(x.dtype), v_first


def setup_inputs(seed: int = 0) -> dict:
    key = jax.random.key(seed)
    ks = iter(jax.random.split(key, 64))
    f32 = jnp.float32

    def nrm(shape, scale):
        return jax.random.normal(next(ks), shape, f32) * scale

    def gain(shape):
        return 1.0 + nrm(shape, 0.05)

    D = D_MODEL
    return {
        'x': nrm((BATCH, SEQ, D), 1.0),
        'p': nrm((DEPTH, BATCH, SEQ, PLE_DIM), 1.0),
        'norms': gain((DEPTH, 4, D)),
        'final_norm': gain((D,)),
        'ffn_wg': nrm((DEPTH, 2, D, D_FF), D ** -0.5),
        'ffn_wu': nrm((DEPTH, 2, D, D_FF), D ** -0.5),
        'ffn_wd': nrm((DEPTH, 2, D_FF, D), 0.5 * D_FF ** -0.5),
        'ple_wp': nrm((DEPTH, PLE_DIM, D), 0.5 * PLE_DIM ** -0.5),
        'ple_wg': nrm((DEPTH, D, D), D ** -0.5),
        'e_w_in': nrm((N_EVEN, D, EVEN_IN), D ** -0.5),
        'e_w_out': nrm((N_EVEN, D, D), 0.5 * D ** -0.5),
        'a_vnorm': gain((N_EVEN, A_WIDTH)),
        'a_ws': nrm((N_EVEN, A_GROUPS, A_CHUNK, A_CHUNK), 0.5 * A_CHUNK ** -0.5),
        'a_bs': 1.0 + nrm((N_EVEN, A_GROUPS, A_CHUNK), 0.1),
        'b_onorm': gain((N_EVEN, B_WIDTH)),
        'b_lb_logits': nrm((DEPTH, B_WIDTH), 0.5),
        'c_mix': jax.random.uniform(next(ks), (N_ODD, 6, D), f32),
        'c_wr': nrm((N_ODD, D, D), D ** -0.5),
        'c_wk': nrm((N_ODD, D, D), D ** -0.5),
        'c_wv': nrm((N_ODD, D, D), D ** -0.5),
        'c_wo': nrm((N_ODD, D, D), 0.5 * D ** -0.5),
        'c_w0': jax.random.uniform(next(ks), (N_ODD, D), f32, -6.0, -1.0),
        'c_w1': nrm((N_ODD, D, C_DECAY_LORA), D ** -0.5),
        'c_w2': nrm((N_ODD, C_DECAY_LORA, D), 0.5 * C_DECAY_LORA ** -0.5),
        'c_a0': nrm((N_ODD, D), 0.5),
        'c_a1': nrm((N_ODD, D, C_AAA_LORA), D ** -0.5),
        'c_a2': nrm((N_ODD, C_AAA_LORA, D), 0.5 * C_AAA_LORA ** -0.5),
        'c_g1': nrm((N_ODD, D, C_GATE_LORA), D ** -0.5),
        'c_g2': nrm((N_ODD, C_GATE_LORA, D), C_GATE_LORA ** -0.5),
        'c_kk': 0.85 + nrm((N_ODD, D), 0.05),
        'c_ka': 1.0 + nrm((N_ODD, D), 0.05),
        'c_rk': nrm((N_ODD, C_HEADS, C_HEAD), 0.1),
        'c_gn_g': gain((N_ODD, D)),
        'c_gn_b': nrm((N_ODD, D), 0.01),
        'c_v0': 1.0 + nrm((N_VRES, D), 0.1),
        'c_v1': nrm((N_VRES, D, C_MV_LORA), 0.5 * D ** -0.5),
        'c_v2': nrm((N_VRES, C_MV_LORA, D), 0.5 * C_MV_LORA ** -0.5),
    }


def reference(x, p, norms, final_norm, ffn_wg, ffn_wu, ffn_wd, ple_wp, ple_wg, e_w_in, e_w_out,
              a_vnorm, a_ws, a_bs, b_onorm, b_lb_logits, c_mix, c_wr, c_wk, c_wv, c_wo, c_w0, c_w1, c_w2,
              c_a0, c_a1, c_a2, c_g1, c_g2, c_kk, c_ka, c_rk, c_gn_g, c_gn_b, c_v0, c_v1, c_v2):
    probs = jax.nn.softmax(b_lb_logits.astype(jnp.float32), axis=0)
    lower_bounds = jnp.cumsum(probs, axis=0) - probs[0]
    split_at = [A_WIDTH, 2 * A_WIDTH, 2 * A_WIDTH + B_WIDTH, 2 * A_WIDTH + 2 * B_WIDTH, 2 * A_WIDTH + 3 * B_WIDTH]
    h = x
    v_first = None
    for i in range(DEPTH):
        j = i // 2
        h = h + 0.5 * swiglu(rmsnorm(h, norms[i, 0]), ffn_wg[i, 0], ffn_wu[i, 0], ffn_wd[i, 0])
        hn = rmsnorm(h, norms[i, 1])
        if i % 2 == 0:
            proj = hn @ e_w_in[j]
            au, av, bq, bf, bi, bg = jnp.split(proj, split_at, axis=-1)
            a_out = chunked_gmlp(jax.nn.gelu(au), jax.nn.gelu(av), a_vnorm[j], a_ws[j], a_bs[j])
            b_o = hgrn2(bq, bf, bi, lower_bounds[i]).astype(hn.dtype)
            bsz, seq, _ = b_o.shape
            b_o = rmsnorm(b_o.reshape(bsz, seq, B_HEADS, B_HEAD_DIM), b_onorm[j].reshape(B_HEADS, B_HEAD_DIM))
            b_out = b_o.reshape(bsz, seq, B_WIDTH) * jax.nn.silu(bg)
            mixed = jnp.concatenate([a_out.astype(hn.dtype), b_out.astype(hn.dtype)], axis=-1) @ e_w_out[j]
        else:
            v_res = None if j == 0 else (c_v0[j - 1], c_v1[j - 1], c_v2[j - 1])
            mixed, v_first = rwkv7(hn, c_mix[j], c_wr[j], c_wk[j], c_wv[j], c_wo[j], c_w0[j], c_w1[j], c_w2[j],
                                   c_a0[j], c_a1[j], c_a2[j], c_g1[j], c_g2[j], c_kk[j], c_ka[j], c_rk[j],
                                   c_gn_g[j], c_gn_b[j], v_first, v_res)
        h = h + mixed.astype(h.dtype)
        h = h + 0.5 * swiglu(rmsnorm(h, norms[i, 2]), ffn_wg[i, 1], ffn_wu[i, 1], ffn_wd[i, 1])
        gate = jax.nn.sigmoid(rmsnorm(h, norms[i, 3]) @ ple_wg[i])
        h = h + gate * (p[i] @ ple_wp[i])
    return rmsnorm(h, final_norm)
```

```cpp
#include <hip/hip_runtime.h>
#include <cstdio>
#include <cstdint>

#ifndef N_LAUNCH_MODE
#define N_LAUNCH_MODE 0
#endif

#define LAS __attribute__((address_space(3)))
#define GAS __attribute__((address_space(1)))
typedef unsigned short bf16_t;
typedef short bf16x8 __attribute__((ext_vector_type(8)));
typedef float f32x4 __attribute__((ext_vector_type(4)));
typedef float f32x2 __attribute__((ext_vector_type(2)));
typedef unsigned u32x4 __attribute__((ext_vector_type(4)));
typedef unsigned u32x2 __attribute__((ext_vector_type(2)));

constexpr int D = 2048, SEQ = 2048, NB = 4, DEPTH = 4, M = NB * SEQ, PLE = 256, FF = 5632;
constexpr int EIN = 6144, RIN_N = 7168, NTHR = 512, NWAVES = 8;
constexpr float RMS_EPS = 1e-6f, GN_EPS = 64e-5f;

constexpr size_t MiB = 1u << 20;
constexpr size_t WS_CTL = 0, CTL_ZERO_BYTES = 65536, WS_SS = 1 * MiB;
constexpr size_t WS_WGU = 2 * MiB, WS_WD = 354 * MiB, WS_WPG = 530 * MiB, WS_WPP = 562 * MiB, WS_WEIN = 566 * MiB, WS_WEOUT = 614 * MiB;
constexpr size_t WS_WRIN = 630 * MiB, WS_WL2 = 686 * MiB, WS_WO = 694 * MiB;
constexpr size_t WS_H = 710 * MiB, WS_HB0 = 774 * MiB, WS_HB1 = 806 * MiB, WS_PB = 838 * MiB, WS_PW = 854 * MiB, WS_VF = 886 * MiB, WS_LB = 918 * MiB;
constexpr size_t WS_LBIAS = WS_LB + 65536;
constexpr size_t WS_UNION = 919 * MiB;
constexpr size_t WS_HF = WS_UNION;
constexpr size_t WS_EA = WS_UNION, WS_LOGF = WS_UNION + 96 * MiB, WS_OI = WS_UNION + 128 * MiB, WS_U = WS_UNION + 160 * MiB, WS_DC = WS_UNION + 224 * MiB, WS_AB = WS_UNION + 225 * MiB;
constexpr size_t WS_XM = WS_UNION, WS_RKV = WS_UNION + 192 * MiB, WS_T = WS_UNION + 288 * MiB, WS_WAGV = WS_UNION + 304 * MiB, WS_Y = WS_UNION + 432 * MiB;
constexpr size_t WS_XG = WS_UNION + 464 * MiB, XG_BYTES = 8 * MiB;
constexpr size_t WS_END = WS_XG + XG_BYTES;
static_assert(WS_WGU + 8ull * 2 * FF * D * 2 <= WS_WD && WS_WD + 8ull * D * FF * 2 <= WS_WPG && WS_WRIN + 2ull * RIN_N * D * 2 <= WS_WL2 && WS_WL2 + 2ull * 8192 * 256 * 2 <= WS_WO, "ws map");
static_assert(WS_HF + (size_t)M * FF * 2 <= WS_END && WS_AB + (size_t)M * D * 2 <= WS_END && WS_Y + (size_t)M * D * 2 <= WS_END, "ws map");
constexpr int CW_TMO = 0, CW_BAR = 4096;

__device__ __forceinline__ float bf2f(unsigned b) { return __uint_as_float(b << 16); }
__device__ __forceinline__ float lo8_dec(float r, unsigned w, int i) { const int eb = (int)(__float_as_uint(r) & 0x7F800000u) - (15 << 23); return (float)(((int)(w << (24 - 8 * i))) >> 24) * __uint_as_float((unsigned)(eb > 0 ? eb : 0)); }
__device__ __forceinline__ unsigned lo8_enc(float n, float r) { const unsigned mb = 0x86800000u - (__float_as_uint(r) & 0x7F800000u); return (unsigned)(int)rintf(fminf(fmaxf((n - r) * __uint_as_float(mb), -128.0f), 127.0f)) & 0xffu; }
__device__ __forceinline__ unsigned lo8_pack(unsigned t0, unsigned t1, unsigned t2, unsigned t3) { return (t0 & 0xffu) | ((t1 & 0xffu) << 8) | ((t2 & 0xffu) << 16) | (t3 << 24); }
typedef __bf16 bf16x2_t __attribute__((ext_vector_type(2)));
__device__ __forceinline__ unsigned cvt_pk_bf16(float lo, float hi) { const f32x2 v = {lo, hi}; const bf16x2_t b = __builtin_convertvector(v, bf16x2_t); return __builtin_bit_cast(unsigned, b); }
__device__ __forceinline__ float sigm(float x) { return __builtin_amdgcn_rcpf(1.0f + __builtin_amdgcn_exp2f(-1.44269504f * x)); }
__device__ __forceinline__ float siluf(float x) { return x * sigm(x); }
__device__ __forceinline__ float tanhf_(float x) { return 2.0f * sigm(2.0f * x) - 1.0f; }
__device__ __forceinline__ float gelu_t(float x) { return x * sigm(1.5957691216f * (x + 0.044715f * x * x * x)); }
__device__ __forceinline__ float expf_(float x) { return __builtin_amdgcn_exp2f(1.44269504f * x); }
__device__ __forceinline__ float logf_(float x) { return 0.69314718056f * __builtin_amdgcn_logf(x); }
__device__ __forceinline__ float rstd_of(float ss) { return __builtin_amdgcn_rsqf(ss * (1.0f / D) + RMS_EPS); }
template <int CTRL> __device__ __forceinline__ float dppf(float v) { return __int_as_float(__builtin_amdgcn_update_dpp(0, __float_as_int(v), CTRL, 0xF, 0xF, true)); }
__device__ __forceinline__ float red4(float v) { v += dppf<0xB1>(v); v += dppf<0x4E>(v); return v; }
__device__ __forceinline__ float red8(float v) { v = red4(v); v += dppf<0x141>(v); return v; }
__device__ __forceinline__ float red16(float v) { v = red8(v); v += dppf<0x140>(v); return v; }
__device__ __forceinline__ float tred16(float (&v)[16], bool b8, bool b4, bool b2, bool b1) {
#pragma unroll
    for (int j = 0; j < 8; ++j) { const float send = b8 ? v[j] : v[j + 8], keep = b8 ? v[j + 8] : v[j]; v[j] = keep + dppf<0x140>(send); }
#pragma unroll
    for (int j = 0; j < 4; ++j) { const float send = b4 ? v[j] : v[j + 4], keep = b4 ? v[j + 4] : v[j]; v[j] = keep + dppf<0x141>(send); }
#pragma unroll
    for (int j = 0; j < 2; ++j) { const float send = b2 ? v[j] : v[j + 2], keep = b2 ? v[j + 2] : v[j]; v[j] = keep + dppf<0x4E>(send); }
    { const float send = b1 ? v[0] : v[1], keep = b1 ? v[1] : v[0]; v[0] = keep + dppf<0xB1>(send); }
    return v[0];
}
__device__ __forceinline__ int lane_id() { int l; asm volatile("v_mbcnt_lo_u32_b32 %0, -1, 0\n\tv_mbcnt_hi_u32_b32 %0, -1, %0" : "=v"(l)); return l; }
__device__ __forceinline__ float shfl_xor_f(float v, int mask) { return __int_as_float(__builtin_amdgcn_ds_bpermute((lane_id() ^ mask) << 2, __float_as_int(v))); }
__device__ __forceinline__ float wave_sum(float v) { v = red16(v); v += shfl_xor_f(v, 16); v += shfl_xor_f(v, 32); return v; }

#define TID_FROM_WAVE(wv) ((wv) * 64 + lane_id())

namespace pg8 {
constexpr int BM = 256, BK = 64, HALF = 128, HTB = HALF * BK * 2, STAGE_BYTES = 8 * HTB, NXCD = 8, WGM = 8;
__host__ __device__ __forceinline__ int lds_byte(int r, int c) { const int st = (r >> 4) * 2 + (c >> 5), rr = r & 15, cc = c & 31, ob = rr * 64 + cc * 2; return st * 1024 + (ob ^ (((ob >> 9) & 1) << 5)); }
__host__ __device__ __forceinline__ void stage_rc(int b, int& R, int& C) { const int st = b / 1024, sb = b % 1024, swz = sb ^ (((sb >> 9) & 1) << 5); R = (st >> 1) * 16 + swz / 64; C = (st & 1) * 32 + (swz % 64) / 2; }
__host__ __device__ __forceinline__ int perm32(int rho) { const int n = rho >> 4, i = rho & 15; return 8 * (i >> 2) + 4 * n + (i & 3); }
struct Unit { int pm, pn; };
struct StaticOrder {
    int nM, nN, nwg, G, c;
    __host__ __device__ void init(int M_, int N_, int G_, int c_) { nM = M_ / BM; nN = N_ / BM; nwg = nM * nN; G = G_; c = c_; }
    __host__ __device__ bool next(int i, Unit& u) const {
        const long L = (long)i * G + c; if (L >= nwg) return false;
        int wgid = (int)L; { const int q = nwg / NXCD, r = nwg % NXCD, xcd = wgid % NXCD, off = wgid / NXCD; wgid = (xcd < r ? xcd * (q + 1) : r * (q + 1) + (xcd - r) * q) + off; }
        const int nig = WGM * nN, gid = wgid / nig, fm = gid * WGM, gsz = (nM - fm) < WGM ? (nM - fm) : WGM;
        u.pm = fm + ((wgid % nig) % gsz); u.pn = (wgid % nig) / gsz; return true;
    }
};
template <int LDA, int LDB, int KK> struct GemmPlain { const bf16_t* A; const bf16_t* Bt; static constexpr int lda = LDA, ldb = LDB, K = KK;
    __device__ __forceinline__ const void* a_base() const { return A; } __device__ __forceinline__ const void* b_base() const { return Bt; }
    __device__ __forceinline__ unsigned a_off(const Unit& u) const { return (unsigned)u.pm * (BM * lda * 2); }
    __device__ __forceinline__ unsigned b_off(const Unit& u) const { return (unsigned)u.pn * (BM * ldb * 2); } };
struct GemmRwkvIn { const bf16_t* XM; const bf16_t* Bt; static constexpr int lda = D, ldb = D, K = D;
    __device__ __forceinline__ const void* a_base() const { return XM; } __device__ __forceinline__ const void* b_base() const { return Bt; }
    __device__ __forceinline__ unsigned a_off(const Unit& u) const { const int s = u.pn < 24 ? (u.pn >> 3) : (u.pn == 27 ? 2 : u.pn - 21); return (unsigned)s * (unsigned)(M * D * 2) + (unsigned)u.pm * (BM * lda * 2); }
    __device__ __forceinline__ unsigned b_off(const Unit& u) const { return (unsigned)u.pn * (BM * ldb * 2); } };
struct GemmLoraOut { const bf16_t* T; const bf16_t* Bt; static constexpr int lda = 1024, ldb = 256, K = 256;
    __device__ __forceinline__ const void* a_base() const { return T; } __device__ __forceinline__ const void* b_base() const { return Bt; }
    __device__ __forceinline__ unsigned a_off(const Unit& u) const { return (unsigned)u.pm * (BM * lda * 2) + (unsigned)(u.pn >> 3) * 512u; }
    __device__ __forceinline__ unsigned b_off(const Unit& u) const { return (unsigned)u.pn * (BM * ldb * 2); } };

#define EPI_ROW(ai, m) (u.pm * BM + (ai) * HALF + wr * 64 + (m) * 16 + fr)
#define EPI_COL(bj)    (u.pn * BM + (bj) * HALF + wc * 32 + 8 * fq)
#define EPI_ARGS const f32x4 (&acc)[2][2][4][2], const Unit& u, int wr, int wc, int fr, int fq
#define EPI_FENCE asm volatile("" ::: "memory")

__device__ __forceinline__ u32x4 pack8(const f32x4 a, const f32x4 b) { u32x4 w; w.x = cvt_pk_bf16(a[0], a[1]); w.y = cvt_pk_bf16(a[2], a[3]); w.z = cvt_pk_bf16(b[0], b[1]); w.w = cvt_pk_bf16(b[2], b[3]); return w; }
__device__ __forceinline__ void unpack8(const u32x4 w, f32x4& a, f32x4& b) { a[0] = bf2f(w.x & 0xffffu); a[1] = bf2f(w.x >> 16); a[2] = bf2f(w.y & 0xffffu); a[3] = bf2f(w.y >> 16); b[0] = bf2f(w.z & 0xffffu); b[1] = bf2f(w.z >> 16); b[2] = bf2f(w.w & 0xffffu); b[3] = bf2f(w.w >> 16); }

struct EpiGU { static constexpr bool PERM = true;
    bf16_t* H; const float* ss;
    __device__ __forceinline__ void operator()(EPI_ARGS) const {
        const int colo = u.pn * 128 + wc * 32 + 8 * fq;
#pragma unroll
        for (int ai = 0; ai < 2; ++ai)
#pragma unroll
            for (int m = 0; m < 4; ++m) { const int row = EPI_ROW(ai, m); const float rs = rstd_of(ss[row]); const float c1 = -1.44269504f * rs, c2 = rs * rs; f32x4 o0, o1;
#pragma unroll
                for (int j = 0; j < 4; ++j) { const float g0 = acc[ai][0][m][0][j], g1 = acc[ai][0][m][1][j];
                    o0[j] = (g0 * acc[ai][1][m][0][j]) * c2 * __builtin_amdgcn_rcpf(1.0f + __builtin_amdgcn_exp2f(g0 * c1));
                    o1[j] = (g1 * acc[ai][1][m][1][j]) * c2 * __builtin_amdgcn_rcpf(1.0f + __builtin_amdgcn_exp2f(g1 * c1)); }
                *(u32x4*)(H + (size_t)row * FF + colo) = pack8(o0, o1); }
    }
};
struct EpiResid { static constexpr bool PERM = true;
    const bf16_t* hin; bf16_t* hout; unsigned char* lo; float* ssn; float scale;
    __device__ __forceinline__ void operator()(EPI_ARGS) const {
#pragma unroll
        for (int ai = 0; ai < 2; ++ai)
#pragma unroll
            for (int m = 0; m < 4; ++m) { const int row = EPI_ROW(ai, m); float sq = 0.f;
#pragma unroll
                for (int bj = 0; bj < 2; ++bj) { const int col = EPI_COL(bj); const size_t o = (size_t)row * D + col;
                    f32x4 a0, a1, b0, b1; unpack8(*(const u32x4*)(hin + o), a0, a1); const u32x2 lw = *(const u32x2*)(lo + o);
#pragma unroll
                    for (int i = 0; i < 4; ++i) { b0[i] = lo8_dec(a0[i], lw.x, i); b1[i] = lo8_dec(a1[i], lw.y, i); }
                    const f32x4 n0 = (a0 + b0) + acc[ai][bj][m][0] * scale, n1 = (a1 + b1) + acc[ai][bj][m][1] * scale;
                    const u32x4 hi = pack8(n0, n1); f32x4 r0, r1; unpack8(hi, r0, r1);
                    u32x2 lq; lq.x = lo8_pack(lo8_enc(n0[0], r0[0]), lo8_enc(n0[1], r0[1]), lo8_enc(n0[2], r0[2]), lo8_enc(n0[3], r0[3])); lq.y = lo8_pack(lo8_enc(n1[0], r1[0]), lo8_enc(n1[1], r1[1]), lo8_enc(n1[2], r1[2]), lo8_enc(n1[3], r1[3]));
                    *(u32x4*)(hout + o) = hi; *(u32x2*)(lo + o) = lq;
                    sq += (n0[0] * n0[0] + n0[1] * n0[1]) + (n0[2] * n0[2] + n0[3] * n0[3]) + (n1[0] * n1[0] + n1[1] * n1[1]) + (n1[2] * n1[2] + n1[3] * n1[3]); }
                sq += shfl_xor_f(sq, 16); sq += shfl_xor_f(sq, 32);
                if (fq == 0) atomicAdd(ssn + row, sq);
                if (m == 3) EPI_FENCE; }
    }
};
struct EpiPLE { static constexpr bool PERM = true;
    const bf16_t* hin; bf16_t* hout; unsigned char* lo; float* ssn; const float* ss; const bf16_t* pw;
    __device__ __forceinline__ void operator()(EPI_ARGS) const {
#pragma unroll
        for (int ai = 0; ai < 2; ++ai)
#pragma unroll
            for (int m = 0; m < 4; ++m) { const int row = EPI_ROW(ai, m); const float rs = rstd_of(ss[row]); float sq = 0.f;
#pragma unroll
                for (int bj = 0; bj < 2; ++bj) { const int col = EPI_COL(bj); const size_t o = (size_t)row * D + col;
                    f32x4 p0, p1; unpack8(*(const u32x4*)(pw + o), p0, p1);
                    f32x4 n0, n1; unpack8(*(const u32x4*)(hin + o), n0, n1); { const u32x2 lw = *(const u32x2*)(lo + o);
#pragma unroll
                      for (int i = 0; i < 4; ++i) { n0[i] += lo8_dec(n0[i], lw.x, i); n1[i] += lo8_dec(n1[i], lw.y, i); } }
#pragma unroll
                    for (int j = 0; j < 4; ++j) { n0[j] += sigm(acc[ai][bj][m][0][j] * rs) * p0[j]; n1[j] += sigm(acc[ai][bj][m][1][j] * rs) * p1[j]; }
                    { const u32x4 hi = pack8(n0, n1); f32x4 r0, r1; unpack8(hi, r0, r1); *(u32x4*)(hout + o) = hi;
                      u32x2 lq; lq.x = lo8_pack(lo8_enc(n0[0], r0[0]), lo8_enc(n0[1], r0[1]), lo8_enc(n0[2], r0[2]), lo8_enc(n0[3], r0[3])); lq.y = lo8_pack(lo8_enc(n1[0], r1[0]), lo8_enc(n1[1], r1[1]), lo8_enc(n1[2], r1[2]), lo8_enc(n1[3], r1[3]));
                      *(u32x2*)(lo + o) = lq; }
                    sq += (n0[0] * n0[0] + n0[1] * n0[1]) + (n0[2] * n0[2] + n0[3] * n0[3]) + (n1[0] * n1[0] + n1[1] * n1[1]) + (n1[2] * n1[2] + n1[3] * n1[3]); }
                sq += shfl_xor_f(sq, 16); sq += shfl_xor_f(sq, 32);
                if (fq == 0) atomicAdd(ssn + row, sq);
                if (m == 3) EPI_FENCE; }
    }
};
struct EpiStore { static constexpr bool PERM = true;
    bf16_t* O; int ldo;
    __device__ __forceinline__ void operator()(EPI_ARGS) const {
#pragma unroll
        for (int ai = 0; ai < 2; ++ai)
#pragma unroll
            for (int m = 0; m < 4; ++m) { const int row = EPI_ROW(ai, m);
#pragma unroll
                for (int bj = 0; bj < 2; ++bj) *(u32x4*)(O + (size_t)row * ldo + EPI_COL(bj)) = pack8(acc[ai][bj][m][0], acc[ai][bj][m][1]); }
    }
};
struct EpiEvenIn { static constexpr bool PERM = true;
    bf16_t* EA; float* LOGF; const float* ss; const float* lb;
    __device__ __forceinline__ void operator()(EPI_ARGS) const {
        const int grp = u.pn >> 2;
#pragma unroll
        for (int ai = 0; ai < 2; ++ai)
#pragma unroll
            for (int m = 0; m < 4; ++m) { const int row = EPI_ROW(ai, m); const float rs = rstd_of(ss[row]);
#pragma unroll
                for (int bj = 0; bj < 2; ++bj) { const int col = EPI_COL(bj); f32x4 v0 = acc[ai][bj][m][0] * rs, v1 = acc[ai][bj][m][1] * rs;
                    if (grp == 3) { const int c = col - 3072; const f32x4 l0 = *(const f32x4*)(lb + c), l1 = *(const f32x4*)(lb + c + 4);
#pragma unroll
                        for (int j = 0; j < 4; ++j) { v0[j] = logf_(fmaxf(l0[j] + (1.0f - l0[j]) * sigm(v0[j]), 1e-30f)); v1[j] = logf_(fmaxf(l1[j] + (1.0f - l1[j]) * sigm(v1[j]), 1e-30f)); }
                        float* lp = LOGF + (size_t)row * 1024 + c; *(f32x4*)lp = v0; *(f32x4*)(lp + 4) = v1;
                    } else {
                        if (grp <= 1) {
#pragma unroll
                            for (int j = 0; j < 4; ++j) { v0[j] = gelu_t(v0[j]); v1[j] = gelu_t(v1[j]); }
                        } else if (grp != 4) {
#pragma unroll
                            for (int j = 0; j < 4; ++j) { v0[j] = siluf(v0[j]); v1[j] = siluf(v1[j]); }
                        }
                        *(u32x4*)(EA + (size_t)row * EIN + col) = pack8(v0, v1);
                    } } }
    }
};
struct EpiRwkvIn { static constexpr bool PERM = true;
    unsigned char* ws; int jodd;
    __device__ __forceinline__ void operator()(EPI_ARGS) const {
        const int pn = u.pn;
        size_t off = WS_RKV + (size_t)(pn >> 3) * M * D * 2; int ld = D, cb = (pn & 7) * BM;
        if (pn >= 16 && jodd == 0) off = WS_VF;
        if (pn >= 24) { off = WS_T; ld = 1024; cb = (pn - 24) * BM; }
        bf16_t* dst = (bf16_t*)(ws + off);
#pragma unroll
        for (int ai = 0; ai < 2; ++ai)
#pragma unroll
            for (int m = 0; m < 4; ++m) { const int row = EPI_ROW(ai, m);
#pragma unroll
                for (int bj = 0; bj < 2; ++bj) { const int col = cb + bj * HALF + wc * 32 + 8 * fq; f32x4 v0 = acc[ai][bj][m][0], v1 = acc[ai][bj][m][1];
                    if (pn == 24) {
#pragma unroll
                        for (int j = 0; j < 4; ++j) { v0[j] = tanhf_(v0[j]); v1[j] = tanhf_(v1[j]); }
                    } else if (pn == 26) {
#pragma unroll
                        for (int j = 0; j < 4; ++j) { v0[j] = sigm(v0[j]); v1[j] = sigm(v1[j]); }
                    }
                    *(u32x4*)(dst + (size_t)row * ld + col) = pack8(v0, v1); } }
    }
};
struct EpiLoraOut { static constexpr bool PERM = true;
    bf16_t* O; const float* bias4;
    __device__ __forceinline__ void operator()(EPI_ARGS) const {
        const int grp = u.pn >> 3;
        bf16_t* dst = O + (size_t)grp * M * D;
#pragma unroll
        for (int bj = 0; bj < 2; ++bj) { const int col = (u.pn & 7) * BM + bj * HALF + wc * 32 + 8 * fq;
            const f32x4 b0 = *(const f32x4*)(bias4 + grp * D + col), b1 = *(const f32x4*)(bias4 + grp * D + col + 4);
#pragma unroll
            for (int ai = 0; ai < 2; ++ai)
#pragma unroll
                for (int m = 0; m < 4; ++m) { const int row = EPI_ROW(ai, m); f32x4 v0_ = acc[ai][bj][m][0] + b0, v1_ = acc[ai][bj][m][1] + b1;
                    if (grp != 2) { const float sc = grp == 0 ? 0.60653065971f : 1.0f;
#pragma unroll
                        for (int j = 0; j < 4; ++j) { v0_[j] = sc * sigm(v0_[j]); v1_[j] = sc * sigm(v1_[j]); } }
                    *(u32x4*)(dst + (size_t)row * D + col) = pack8(v0_, v1_); } }
    }
};

template <class Epi, class G, bool ALIGN_EPI = true, bool SP2 = true>
__device__ __forceinline__ void gemm_phase(LAS unsigned char* lds, const G g, const StaticOrder& S, const Epi& E, int wv) {
    asm volatile("" : "+s"(wv));
    const int lane = lane_id();
    const int wid = wv, tid = wv * 64 + lane, wr = wid >> 2, wc = wid & 3, fr = lane & 15, fq = lane >> 4;
    constexpr int K = G::K, nt = K / BK, lda = G::lda, ldb = G::ldb;
    unsigned voffA[2], voffB[2];
#pragma unroll
    for (int i = 0; i < 2; ++i) { int R, C; stage_rc(tid * 16 + i * 8192, R, C); const int Rb = Epi::PERM ? ((R & ~31) + perm32(R & 31)) : R;
        voffA[i] = (unsigned)(R * lda + C) * 2u; voffB[i] = (unsigned)(Rb * ldb + C) * 2u; }
    constexpr unsigned kstep = BK * 2u, hstepA = (unsigned)(HALF * lda * 2), hstepB = (unsigned)(HALF * ldb * 2);
    const __amdgpu_buffer_rsrc_t rsA = __builtin_amdgcn_make_buffer_rsrc((void*)g.a_base(), (short)0, 0x7FFFFFF0, 0x00020000), rsB = __builtin_amdgcn_make_buffer_rsrc((void*)g.b_base(), (short)0, 0x7FFFFFF0, 0x00020000);
    const unsigned ldsw = (unsigned)wid * 1024u;
    const int aoff = lds_byte(wr * 64 + fr, fq * 8), boff = lds_byte(wc * 32 + fr, fq * 8);
#define PG8_SA(b, h) (((b) * 2 + (h)) * HTB)
#define PG8_SB(b, h) ((4 + (b) * 2 + (h)) * HTB)
#define PG8_STAGE(bufoff, rs, soff, voff) do { _Pragma("unroll") for (int _i = 0; _i < 2; ++_i) \
        __builtin_amdgcn_raw_ptr_buffer_load_lds((rs), (LAS void*)(lds + (bufoff) + ldsw + _i * 8192), 16, (int)(voff)[_i], (int)(soff), 0, 0); } while (0)
#define PG8_LDA(dst, b, h) do { _Pragma("unroll") for (int m = 0; m < 4; ++m) _Pragma("unroll") for (int k = 0; k < 2; ++k) dst[m][k] = *(const LAS bf16x8*)(lds + PG8_SA(b, h) + aoff + m * 2048 + k * 1024); } while (0)
#define PG8_LDB(dst, b, h) do { _Pragma("unroll") for (int n = 0; n < 2; ++n) _Pragma("unroll") for (int k = 0; k < 2; ++k) dst[n][k] = *(const LAS bf16x8*)(lds + PG8_SB(b, h) + boff + n * 2048 + k * 1024); } while (0)
#define PG8_MMA(ai, bj, At, Bt) do { __builtin_amdgcn_s_setprio(1); _Pragma("unroll") for (int m = 0; m < 4; ++m) _Pragma("unroll") for (int n = 0; n < 2; ++n) _Pragma("unroll") for (int k = 0; k < 2; ++k) \
        acc[ai][bj][m][n] = __builtin_amdgcn_mfma_f32_16x16x32_bf16(Bt[n][k], At[m][k], acc[ai][bj][m][n], 0, 0, 0); __builtin_amdgcn_s_setprio(0); } while (0)
#define PG8_WAIT_V(n) asm volatile("s_waitcnt vmcnt(" #n ")" ::: "memory")
#define PG8_WAIT_L(n) asm volatile("s_waitcnt lgkmcnt(" #n ")" ::: "memory")
#define PG8_BAR __builtin_amdgcn_s_barrier()
#define PG8_SCHED __builtin_amdgcn_sched_barrier(0)
    Unit cur, nxt; int ui = 0;
    if (!S.next(0, cur)) return;
    f32x4 acc[2][2][4][2];
#pragma unroll
    for (int a = 0; a < 2; ++a)
#pragma unroll
        for (int b = 0; b < 2; ++b)
#pragma unroll
            for (int m = 0; m < 4; ++m)
#pragma unroll
                for (int n = 0; n < 2; ++n) acc[a][b][m][n] = (f32x4){0.f, 0.f, 0.f, 0.f};
    bf16x8 At[4][2], B0[2][2], B1[2][2];
    unsigned cA = g.a_off(cur), cB = g.b_off(cur);
    if constexpr (SP2) {
        PG8_STAGE(PG8_SB(0, 0), rsB, cB, voffB); PG8_STAGE(PG8_SB(0, 1), rsB, cB + hstepB, voffB); PG8_STAGE(PG8_SA(0, 0), rsA, cA, voffA); PG8_STAGE(PG8_SA(0, 1), rsA, cA + hstepA, voffA);
        if (wr == 1) PG8_BAR;
        PG8_WAIT_V(2); PG8_BAR;
        PG8_STAGE(PG8_SB(1, 0), rsB, cB + kstep, voffB); PG8_STAGE(PG8_SA(1, 0), rsA, cA + kstep, voffA); PG8_STAGE(PG8_SB(1, 1), rsB, cB + hstepB + kstep, voffB);
        PG8_WAIT_V(6); PG8_BAR;
    } else {
        PG8_STAGE(PG8_SB(0, 0), rsB, cB, voffB); PG8_STAGE(PG8_SA(0, 0), rsA, cA, voffA); PG8_STAGE(PG8_SB(0, 1), rsB, cB + hstepB, voffB); PG8_STAGE(PG8_SA(0, 1), rsA, cA + hstepA, voffA);
        if (wr == 1) PG8_BAR;
        PG8_WAIT_V(4); PG8_BAR;
        PG8_STAGE(PG8_SB(1, 0), rsB, cB + kstep, voffB); PG8_STAGE(PG8_SA(1, 0), rsA, cA + kstep, voffA); PG8_STAGE(PG8_SB(1, 1), rsB, cB + hstepB + kstep, voffB);
        PG8_WAIT_V(6); PG8_BAR;
    }
    for (;;) {
        const bool has_next = S.next(ui + 1, nxt);
        const unsigned nA = has_next ? g.a_off(nxt) : cA, nB = has_next ? g.b_off(nxt) : cB;
        for (int t = 0; t < nt; t += 2) {
            const bool last = (t == nt - 2);
            const unsigned a1 = cA + (unsigned)(t + 1) * kstep;
            const unsigned a2 = last ? nA : cA + (unsigned)(t + 2) * kstep, b2 = last ? nB : cB + (unsigned)(t + 2) * kstep;
            const unsigned a3 = a2 + kstep, b3 = b2 + kstep;
            if constexpr (SP2) {
            PG8_LDB(B0, 0, 0); PG8_LDB(B1, 0, 1); PG8_SCHED; PG8_LDA(At, 0, 0); PG8_STAGE(PG8_SA(1, 1), rsA, a1 + hstepA, voffA);
            PG8_WAIT_V(8); PG8_WAIT_L(0); PG8_BAR; PG8_MMA(0, 0, At, B0); PG8_MMA(0, 1, At, B1); PG8_BAR; PG8_SCHED;
            PG8_LDA(At, 0, 1); PG8_STAGE(PG8_SB(0, 0), rsB, b2, voffB); PG8_STAGE(PG8_SB(0, 1), rsB, b2 + hstepB, voffB); PG8_STAGE(PG8_SA(0, 0), rsA, a2, voffA);
            PG8_WAIT_V(8); PG8_WAIT_L(0); PG8_BAR; PG8_MMA(1, 0, At, B0); PG8_MMA(1, 1, At, B1); PG8_BAR; PG8_SCHED;
            PG8_LDB(B0, 1, 0); PG8_LDB(B1, 1, 1); PG8_SCHED; PG8_LDA(At, 1, 0); PG8_STAGE(PG8_SA(0, 1), rsA, a2 + hstepA, voffA);
            PG8_WAIT_V(8); PG8_WAIT_L(0); PG8_BAR; PG8_MMA(0, 0, At, B0); PG8_MMA(0, 1, At, B1); PG8_BAR; PG8_SCHED;
            PG8_LDA(At, 1, 1); PG8_STAGE(PG8_SB(1, 0), rsB, b3, voffB); PG8_STAGE(PG8_SB(1, 1), rsB, b3 + hstepB, voffB); PG8_STAGE(PG8_SA(1, 0), rsA, a3, voffA);
            PG8_WAIT_V(8); PG8_WAIT_L(0); PG8_BAR; PG8_MMA(1, 0, At, B0); PG8_MMA(1, 1, At, B1); PG8_BAR; PG8_SCHED;
            } else {
            PG8_LDB(B0, 0, 0); PG8_SCHED; PG8_LDA(At, 0, 0); PG8_STAGE(PG8_SA(1, 1), rsA, a1 + hstepA, voffA);
            PG8_WAIT_L(8); PG8_BAR; PG8_WAIT_L(0); PG8_MMA(0, 0, At, B0); PG8_BAR; PG8_SCHED;
            PG8_LDB(B1, 0, 1); PG8_STAGE(PG8_SB(0, 0), rsB, b2, voffB);
            PG8_BAR; PG8_WAIT_L(0); PG8_MMA(0, 1, At, B1); PG8_BAR;
            PG8_LDA(At, 0, 1); PG8_STAGE(PG8_SA(0, 0), rsA, a2, voffA);
            PG8_BAR; PG8_WAIT_L(0); PG8_MMA(1, 0, At, B0); PG8_BAR; PG8_SCHED;
            PG8_STAGE(PG8_SB(0, 1), rsB, b2 + hstepB, voffB);
            PG8_WAIT_V(6); PG8_BAR; PG8_MMA(1, 1, At, B1); PG8_BAR;
            PG8_LDB(B0, 1, 0); PG8_SCHED; PG8_LDA(At, 1, 0); PG8_STAGE(PG8_SA(0, 1), rsA, a2 + hstepA, voffA);
            PG8_WAIT_L(8); PG8_BAR; PG8_WAIT_L(0); PG8_MMA(0, 0, At, B0); PG8_BAR; PG8_SCHED;
            PG8_LDB(B1, 1, 1); PG8_STAGE(PG8_SB(1, 0), rsB, b3, voffB);
            PG8_BAR; PG8_WAIT_L(0); PG8_MMA(0, 1, At, B1); PG8_BAR;
            PG8_LDA(At, 1, 1); PG8_STAGE(PG8_SA(1, 0), rsA, a3, voffA);
            PG8_BAR; PG8_WAIT_L(0); PG8_MMA(1, 0, At, B0); PG8_BAR; PG8_SCHED;
            PG8_STAGE(PG8_SB(1, 1), rsB, b3 + hstepB, voffB);
            PG8_WAIT_V(6); PG8_BAR; PG8_MMA(1, 1, At, B1); PG8_BAR;
            }
        }
        if constexpr (ALIGN_EPI) { if (wr == 0) PG8_BAR; }
        { const int le = lane_id(); E(acc, cur, wr, wc, le & 15, le >> 4); }
        if (!has_next) break;
#pragma unroll
        for (int a = 0; a < 2; ++a)
#pragma unroll
            for (int b = 0; b < 2; ++b)
#pragma unroll
                for (int m = 0; m < 4; ++m)
#pragma unroll
                    for (int n = 0; n < 2; ++n) acc[a][b][m][n] = (f32x4){0.f, 0.f, 0.f, 0.f};
        cur = nxt; cA = nA; cB = nB; ++ui;
        if constexpr (ALIGN_EPI) { if (wr == 1) PG8_BAR; }
    }
    PG8_WAIT_V(0);
    if constexpr (!ALIGN_EPI) { if (wr == 0) PG8_BAR; }
    PG8_BAR;
#undef PG8_SA
#undef PG8_SB
#undef PG8_STAGE
#undef PG8_LDA
#undef PG8_LDB
#undef PG8_MMA
#undef PG8_WAIT_V
#undef PG8_WAIT_L
#undef PG8_BAR
#undef PG8_SCHED
}
}

constexpr int LDS_BYTES = 148480, MISC_OFF = 147456;

#define XB_TMO      128
#define XB_XCNT(j)  (256  + 64 * (j))
#define XB_XSUB(j)  (1280 + 64 * (j))
#define XB_XGEN(j)  (2304 + 64 * (j))
#define XB_TOP      3328
#define XB_TOPGEN   3392
#define XCD_BAR_WORDS 3456
#define XB_SPIN_CAP (1u << 18)
__device__ __forceinline__ unsigned xb_ld(unsigned* p)              { return __hip_atomic_load(p, __ATOMIC_RELAXED, __HIP_MEMORY_SCOPE_AGENT); }
__device__ __forceinline__ unsigned xb_add(unsigned* p, unsigned v) { return __hip_atomic_fetch_add(p, v, __ATOMIC_RELAXED, __HIP_MEMORY_SCOPE_AGENT); }
__device__ __forceinline__ unsigned xb_xcc_id() { return (unsigned)__builtin_amdgcn_s_getreg((3 << 11) | 20) & 0xFu; }
#define XB_SPIN(cond, bar) do { unsigned _sp = 0; while (cond) { __builtin_amdgcn_s_sleep(1); \
    if ((++_sp & 255u) == 0u) { if (xb_ld(&(bar)[XB_TMO])) break; if (_sp > XB_SPIN_CAP) { atomicAdd(&(bar)[XB_TMO], 1u); break; } } } } while (0)
struct XcdBarrier { unsigned* bar; unsigned x; volatile LAS unsigned* st; };
__device__ __forceinline__ XcdBarrier xcd_barrier_post(unsigned* bar, volatile LAS unsigned* st) {
    XcdBarrier b; b.bar = bar; b.x = xb_xcc_id(); b.st = st;
    if (threadIdx.x == 0) (void)xb_add(&bar[XB_XCNT(b.x)], 1u);
    return b;
}
__device__ __forceinline__ void xcd_barrier_complete(unsigned* bar, unsigned x, unsigned& nloc, unsigned& nx) {
    const unsigned G = gridDim.x * gridDim.y * gridDim.z;
    unsigned sum, cnt, mine, sp = 0u;
    for (;;) {
        sum = 0u; cnt = 0u; mine = 0u;
#pragma unroll
        for (unsigned j = 0; j < 16; ++j) { const unsigned c = xb_ld(&bar[XB_XCNT(j)]); sum += c; cnt += (c > 0u) ? 1u : 0u; mine = (j == x) ? c : mine; }
        if (sum == G) break;
        __builtin_amdgcn_s_sleep(1);
        if ((++sp & 255u) == 0u) { if (xb_ld(&bar[XB_TMO])) break; if (sp > XB_SPIN_CAP) { atomicAdd(&bar[XB_TMO], 1u); break; } }
    }
    nloc = mine > 0u ? mine : 1u; nx = cnt > 0u ? cnt : 1u;
}
__device__ __forceinline__ void xcd_barrier(const XcdBarrier& b, int wv) {
    asm volatile("" : "+s"(wv));
    asm volatile("s_waitcnt vmcnt(0)" ::: "memory");
    __syncthreads();
    if (wv == 0 && lane_id() == 0) {
        unsigned* bar = b.bar;
        __builtin_amdgcn_s_waitcnt(0);
        unsigned nloc = b.st[0], nx = b.st[1];
        if (nloc == 0u) { xcd_barrier_complete(bar, b.x, nloc, nx); b.st[0] = nloc; b.st[1] = nx; }
        const unsigned old = xb_add(&bar[XB_XSUB(b.x)], 1u);
        const unsigned gen = old / nloc;
        if (old + 1u == (gen + 1u) * nloc) {
            __builtin_amdgcn_fence(__ATOMIC_RELEASE, "agent");
            asm volatile("s_waitcnt vmcnt(0)" ::: "memory");
            const unsigned og = xb_add(&bar[XB_TOP], 1u);
            const unsigned tg = og / nx;
            if (og + 1u == (tg + 1u) * nx) xb_add(&bar[XB_TOPGEN], 1u);
            else XB_SPIN(xb_ld(&bar[XB_TOPGEN]) == tg, bar);
            __builtin_amdgcn_fence(__ATOMIC_ACQUIRE, "agent");
            xb_add(&bar[XB_XGEN(b.x)], 1u);
            asm volatile("s_waitcnt vmcnt(0)" ::: "memory");
        } else {
            XB_SPIN(xb_ld(&bar[XB_XGEN(b.x)]) == gen, bar);
            __builtin_amdgcn_fence(__ATOMIC_ACQUIRE, "agent");
            asm volatile("s_waitcnt vmcnt(0)" ::: "memory");
        }
    }
    __syncthreads();
}

template <int NC> __device__ __forceinline__ void tr_load(const float* W, int N, int k0, int n0, f32x4 (&x)[NC][4], int lane) {
    const int i = lane & 15, fq = lane >> 4; const int k1 = k0 + 8 * (i >> 2) + (i & 3), k2 = k1 + 4;
    const float* p1 = W + (size_t)k1 * N + n0 + 8 * fq; const float* p2 = W + (size_t)k2 * N + n0 + 8 * fq;
#pragma unroll
    for (int c = 0; c < NC; ++c) { x[c][0] = *(const f32x4*)(p1 + 32 * c); x[c][1] = *(const f32x4*)(p1 + 32 * c + 4); x[c][2] = *(const f32x4*)(p2 + 32 * c); x[c][3] = *(const f32x4*)(p2 + 32 * c + 4); }
}
template <int NC> __device__ __forceinline__ void tr_finish(bf16_t* WT, int ldk, int k0, int drow0, const float* gain, const f32x4 (&x)[NC][4], int lane) {
    const int i = lane & 15, fq = lane >> 4; const int k1 = k0 + 8 * (i >> 2) + (i & 3), k2 = k1 + 4;
    const float g1 = gain ? gain[k1] : 1.0f, g2 = gain ? gain[k2] : 1.0f;
    u32x4 s0, s1;
    { unsigned e0[8], e1[8];
#pragma unroll
      for (int e = 0; e < 8; ++e) { e0[e] = (8 * fq + e == i) ? 0x3F80u : 0u; e1[e] = (8 * fq + e == 16 + i) ? 0x3F80u : 0u; }
      s0 = (u32x4){e0[0] | (e0[1] << 16), e0[2] | (e0[3] << 16), e0[4] | (e0[5] << 16), e0[6] | (e0[7] << 16)}; s1 = (u32x4){e1[0] | (e1[1] << 16), e1[2] | (e1[3] << 16), e1[4] | (e1[5] << 16), e1[6] | (e1[7] << 16)}; }
    const bf16x8 I0 = __builtin_bit_cast(bf16x8, s0), I1 = __builtin_bit_cast(bf16x8, s1);
    const f32x4 z = (f32x4){0.f, 0.f, 0.f, 0.f};
#pragma unroll
    for (int c = 0; c < NC; ++c) { const bf16x8 A1 = __builtin_bit_cast(bf16x8, pg8::pack8(x[c][0] * g1, x[c][1] * g1)), A2 = __builtin_bit_cast(bf16x8, pg8::pack8(x[c][2] * g2, x[c][3] * g2));
        const f32x4 d00 = __builtin_amdgcn_mfma_f32_16x16x32_bf16(A1, I0, z, 0, 0, 0), d01 = __builtin_amdgcn_mfma_f32_16x16x32_bf16(A2, I0, z, 0, 0, 0);
        const f32x4 d10 = __builtin_amdgcn_mfma_f32_16x16x32_bf16(A1, I1, z, 0, 0, 0), d11 = __builtin_amdgcn_mfma_f32_16x16x32_bf16(A2, I1, z, 0, 0, 0);
        *(u32x4*)(WT + (size_t)(drow0 + 32 * c + i) * ldk + k0 + 8 * fq) = pg8::pack8(d00, d01);
        *(u32x4*)(WT + (size_t)(drow0 + 32 * c + 16 + i) * ldk + k0 + 8 * fq) = pg8::pack8(d10, d11); }
}
template <int NC> __device__ __forceinline__ void tr_mfma(const float* W, int N, bf16_t* WT, int ldk, int k0, int n0, int drow0, const float* gain, int lane) {
    f32x4 x[NC][4]; tr_load<NC>(W, N, k0, n0, x, lane); tr_finish<NC>(WT, ldk, k0, drow0, gain, x, lane);
}

struct Args { const float* in[37]; float* out; unsigned char* ws; int ph_lo, ph_hi, use_bar, pad; };
typedef __attribute__((address_space(4))) const Args* KArgs;
__device__ __forceinline__ KArgs kargs() { KArgs p = (KArgs)__builtin_amdgcn_kernarg_segment_ptr(); asm volatile("" : "+s"(p)); return p; }
enum { I_X = 0, I_P, I_NORMS, I_FNORM, I_WG, I_WU, I_WDN, I_PWP, I_PWG, I_EIN, I_EOUT, I_AVN, I_AWS, I_ABS, I_BON, I_BLB, I_CMIX, I_CWR, I_CWK, I_CWV, I_CWO,
       I_CW0, I_CW1, I_CW2, I_CA0, I_CA1, I_CA2, I_CG1, I_CG2, I_CKK, I_CKA, I_CRK, I_CGNG, I_CGNB, I_CV0, I_CV1, I_CV2 };

struct CJob { int in_idx; unsigned src_off; int N; unsigned long long dst_off; int ldk; int nblk; int nc; int mode  ; int rowoff; int gain_off; int end; };
constexpr int NJOBS = 51;
struct CJobTable { CJob j[NJOBS]; int n; };
constexpr CJob mk_job(int in_idx, unsigned src_off, int K, int N, unsigned long long dst_off, int ldk, int nc, int mode, int rowoff, int gain_off) {
    return CJob{in_idx, src_off, N, dst_off, ldk, N / (32 * nc), nc, mode, rowoff, gain_off, (K / 32) * (N / (32 * nc))}; }
constexpr void add_gu(CJobTable& t, int m) {
    const int gain = ((m >> 1) * 4 + ((m & 1) ? 2 : 0)) * D;
    t.j[t.n++] = mk_job(4, (unsigned)m * D * FF, D, FF, WS_WGU + (unsigned long long)m * 2 * FF * D * 2, D, 2, 1, 0, gain);
    t.j[t.n++] = mk_job(5, (unsigned)m * D * FF, D, FF, WS_WGU + (unsigned long long)m * 2 * FF * D * 2, D, 2, 2, 0, gain); }
constexpr void add_dn(CJobTable& t, int m) { t.j[t.n++] = mk_job(6, (unsigned)m * FF * D, FF, D, WS_WD + (unsigned long long)m * D * FF * 2, FF, 2, 0, 0, -1); }
constexpr void add_ffn(CJobTable& t, int m) { add_gu(t, m); add_dn(t, m); }
constexpr void add_ple(CJobTable& t, int l) {
    t.j[t.n++] = mk_job(7, (unsigned)l * PLE * D, PLE, D, WS_WPP + (unsigned long long)l * D * PLE * 2, PLE, 2, 0, 0, -1);
    t.j[t.n++] = mk_job(8, (unsigned)l * D * D, D, D, WS_WPG + (unsigned long long)l * D * D * 2, D, 2, 0, 0, (l * 4 + 3) * D); }
constexpr void add_even(CJobTable& t, int jj) {
    t.j[t.n++] = mk_job(9, (unsigned)jj * D * EIN, D, EIN, WS_WEIN + (unsigned long long)jj * EIN * D * 2, D, 2, 0, 0, (jj * 8 + 1) * D);
    t.j[t.n++] = mk_job(10, (unsigned)jj * D * D, D, D, WS_WEOUT + (unsigned long long)jj * D * D * 2, D, 2, 0, 0, -1); }
constexpr void add_rin(CJobTable& t, int jj) {
    const unsigned long long dst = WS_WRIN + (unsigned long long)jj * RIN_N * D * 2;
    t.j[t.n++] = mk_job(17, (unsigned)jj * D * D, D, D, dst, D, 2, 0, 0, -1);
    t.j[t.n++] = mk_job(18, (unsigned)jj * D * D, D, D, dst, D, 2, 0, D, -1);
    t.j[t.n++] = mk_job(19, (unsigned)jj * D * D, D, D, dst, D, 2, 0, 2 * D, -1);
    t.j[t.n++] = mk_job(22, (unsigned)jj * D * 96, D, 96, dst, D, 1, 0, 6144, -1);
    t.j[t.n++] = mk_job(25, (unsigned)jj * D * 96, D, 96, dst, D, 1, 0, 6400, -1);
    t.j[t.n++] = mk_job(27, (unsigned)jj * D * 256, D, 256, dst, D, 2, 0, 6656, -1);
    if (jj == 1) t.j[t.n++] = mk_job(35, 0u, D, 64, dst, D, 2, 0, 6912, -1); }
constexpr void add_wo(CJobTable& t, int jj) { t.j[t.n++] = mk_job(20, (unsigned)jj * D * D, D, D, WS_WO + (unsigned long long)jj * D * D * 2, D, 2, 0, 0, -1); }
constexpr int N_STAGE_A_JOBS = 2 + 2 + 2 + 2 + 2 + 6;
constexpr CJobTable make_jobs() {
    CJobTable t{}; t.n = 0;
    add_gu(t, 0); add_even(t, 0); add_gu(t, 1); add_ple(t, 0); add_gu(t, 2); add_rin(t, 0);
    add_dn(t, 0); add_dn(t, 1); add_dn(t, 2);
    add_wo(t, 0); add_ffn(t, 3); add_ple(t, 1);
    add_ffn(t, 4); add_even(t, 1); add_ffn(t, 5); add_ple(t, 2);
    add_ffn(t, 6); add_rin(t, 1);
    add_wo(t, 1); add_ffn(t, 7); add_ple(t, 3);
    int acc = 0; for (int i = 0; i < t.n; ++i) { acc += t.j[i].end; t.j[i].end = acc; }
    return t; }
constexpr CJobTable CJT_H = make_jobs();
static_assert(CJT_H.n == NJOBS, "job count");
constexpr int CV_A = CJT_H.j[N_STAGE_A_JOBS - 1].end, CV_ALL = CJT_H.j[NJOBS - 1].end;
__device__ const CJobTable CJT = make_jobs();
constexpr int CVQ_TAIL = (FF / 32) * (D / 64), CVQ_N = 8;
constexpr int CVQ_LATE = (CV_ALL - CV_A - 3 * CVQ_TAIL) > 0 ? 0 : 0;
constexpr int cvq_end(int k) {
    const int total = CV_ALL - CV_A;
    return k < 3 ? (k + 1) * CVQ_TAIL : (k == 3 ? 81176 : (k == 4 ? 86676 : (k == 5 ? 93676 : (k == 6 ? 99176 : (k == 7 ? 106176 : (k == 8 ? total - 2048 : total)))))); }
static_assert(CV_ALL - CV_A == 127424 && CJT_H.j[N_STAGE_A_JOBS + 2].end - CV_A == 3 * CVQ_TAIL && (cvq_end(3) - cvq_end(2) + 1023) / 1024 <= 64 && (cvq_end(8) - cvq_end(7) + 1023) / 1024 <= 64 && cvq_end(9) == CV_ALL - CV_A, "conversion quotas");

struct TrDesc { const float* W; bf16_t* WT; const float* gain; int N, ldk, k0, n0, drow, nc, mode, rowoff, jend; };
__device__ __forceinline__ TrDesc tr_decode(int it) {
    KArgs ap = kargs();
    int jb = 0;
#pragma unroll 1
    for (int stp = 32; stp >= 1; stp >>= 1) { const int c = jb + stp; if (c < NJOBS && CJT.j[c - 1].end <= it) jb = c; }
    const CJob J = CJT.j[jb]; const int item = it - (jb ? CJT.j[jb - 1].end : 0);
    const int kb = item / J.nblk, nb = item % J.nblk; const int n0 = nb * 32 * J.nc;
    TrDesc d; d.W = ap->in[J.in_idx] + J.src_off; d.WT = (bf16_t*)(ap->ws + J.dst_off); d.gain = J.gain_off >= 0 ? ap->in[2] + J.gain_off : nullptr;
    d.N = J.N; d.ldk = J.ldk; d.k0 = 32 * kb; d.n0 = n0; d.drow = J.mode == 0 ? J.rowoff + n0 : 256 * (n0 >> 7) + (n0 & 127) + (J.mode == 2 ? 128 : 0); d.nc = J.nc; d.mode = J.mode; d.rowoff = J.rowoff; d.jend = J.end;
    return d;
}
__device__ __forceinline__ void tr_next(TrDesc& d, int it) {
    if (it >= d.jend) { d = tr_decode(it); return; }
    d.n0 += 32 * d.nc; if (d.n0 >= d.N) { d.n0 = 0; d.k0 += 32; }
    d.drow = d.mode == 0 ? d.rowoff + d.n0 : 256 * (d.n0 >> 7) + (d.n0 & 127) + (d.mode == 2 ? 128 : 0);
}
__device__ __forceinline__ void convert_items(int lo, int hi, int gw, int NGW, int lane) {
    for (int it = lo + gw; it < hi; it += NGW) { const TrDesc d = tr_decode(it);
        if (d.nc == 2) tr_mfma<2>(d.W, d.N, d.WT, d.ldk, d.k0, d.n0, d.drow, d.gain, lane); else tr_mfma<1>(d.W, d.N, d.WT, d.ldk, d.k0, d.n0, d.drow, d.gain, lane); }
}

__device__ __forceinline__ void prologue(LAS unsigned char* lds, int G, int wv) {
    KArgs ap = kargs();
#define a (*ap)
    asm volatile("" : "+s"(wv)); int tid = TID_FROM_WAVE(wv);
    const int lane = tid & 63, wave = wv;
    unsigned char* ws = a.ws;
    int bid = blockIdx.x; asm volatile("" : "+s"(bid), "+s"(G)); const int gw = bid * NWAVES + wave, NGW = G * NWAVES;
    convert_items(0, CV_A, gw, NGW, lane);
    const size_t gt = (size_t)bid * NTHR + tid, GT = (size_t)G * NTHR;
    for (size_t i = gt; i < (size_t)16 * M / 4; i += GT) *(u32x4*)((float*)(ws + WS_SS) + M + i * 4) = (u32x4){0u, 0u, 0u, 0u};
    for (size_t i = gt; i < XG_BYTES / 16; i += GT) *(u32x4*)(ws + WS_XG + i * 16) = (u32x4){0u, 0u, 0u, 0u};
    for (size_t i = gt; i < (size_t)2 * 512 * (D / 8); i += GT) { const int mat = (int)(i / (512 * (D / 8))); const int rr = (int)(i % (512 * (D / 8))); const int pr = rr / (D / 8), ck = rr % (D / 8);
        const int row = pr < 160 ? 6240 + pr : (pr < 320 ? 6496 + (pr - 160) : 6976 + (pr - 320));
        *(u32x4*)((bf16_t*)(ws + WS_WRIN) + ((size_t)mat * RIN_N + row) * D + ck * 8) = (u32x4){0u, 0u, 0u, 0u}; }
    for (size_t i = gt; i < (size_t)2 * 8192 * 32; i += GT) { const int mat = (int)(i / (8192 * 32)); const int rr = (int)(i % (8192 * 32)); const int ko = rr / 8192, n = rr % 8192; const int grp = n >> 11, nn = n & 2047;
        const float* src; int ks;
        if (grp == 0) { src = a.in[I_CW2] + (size_t)mat * 96 * D; ks = 96; } else if (grp == 1) { src = a.in[I_CA2] + (size_t)mat * 96 * D; ks = 96; }
        else if (grp == 2) { src = a.in[I_CG2] + (size_t)mat * 256 * D; ks = 256; } else { src = a.in[I_CV2]; ks = mat == 1 ? 64 : 0; }
        float v[8];
#pragma unroll
        for (int q = 0; q < 8; ++q) { const int k = ko * 8 + q; v[q] = k < ks ? src[(size_t)k * D + nn] : 0.f; }
        u32x4 o; o.x = cvt_pk_bf16(v[0], v[1]); o.y = cvt_pk_bf16(v[2], v[3]); o.z = cvt_pk_bf16(v[4], v[5]); o.w = cvt_pk_bf16(v[6], v[7]);
        *(u32x4*)((bf16_t*)(ws + WS_WL2) + ((size_t)mat * 8192 + n) * 256 + ko * 8) = o; }
    for (size_t i = gt; i < (size_t)DEPTH * M * PLE / 8; i += GT) { const f32x4 x0 = *(const f32x4*)(a.in[I_P] + i * 8), x1 = *(const f32x4*)(a.in[I_P] + i * 8 + 4);
        *(u32x4*)((bf16_t*)(ws + WS_PB) + i * 8) = pg8::pack8(x0, x1); }
    for (size_t i = gt; i < 1024; i += GT) { const float* lg = a.in[I_BLB]; const float l0 = lg[i], l1 = lg[1024 + i], l2 = lg[2048 + i], l3 = lg[3072 + i];
        const float mx = fmaxf(fmaxf(l0, l1), fmaxf(l2, l3)); const float e0 = expf_(l0 - mx), e1 = expf_(l1 - mx), e2 = expf_(l2 - mx), e3 = expf_(l3 - mx); const float inv = 1.0f / (e0 + e1 + e2 + e3);
        float* lb = (float*)(ws + WS_LB); lb[i] = 0.f; lb[1024 + i] = e1 * inv; lb[2048 + i] = (e1 + e2) * inv; lb[3072 + i] = (e1 + e2 + e3) * inv; }
    for (size_t i = gt; i < (size_t)2 * 4 * D; i += GT) { const int jj = (int)(i / (4 * D)), g4 = (int)((i / D) & 3), c = (int)(i % D);
        float v = 0.f; if (g4 == 0) v = a.in[I_CW0][jj * D + c]; else if (g4 == 1) v = a.in[I_CA0][jj * D + c]; else if (g4 == 3) v = a.in[I_CV0][c];
        ((float*)(ws + WS_LBIAS))[i] = v; }
    for (int row = gw; row < M; row += NGW) { const float* xr = a.in[I_X] + (size_t)row * D; unsigned char* lr = ws + WS_H + (size_t)row * D; bf16_t* br = (bf16_t*)(ws + WS_HB1) + (size_t)row * D; float s = 0.f;
#pragma unroll
        for (int j = 0; j < 4; ++j) { const int c = (j * 64 + lane) * 8; const f32x4 x0 = *(const f32x4*)(xr + c), x1 = *(const f32x4*)(xr + c + 4);
            { const u32x4 hi = pg8::pack8(x0, x1); f32x4 r0, r1; pg8::unpack8(hi, r0, r1); *(u32x4*)(br + c) = hi; u32x2 lq; lq.x = lo8_pack(lo8_enc(x0[0], r0[0]), lo8_enc(x0[1], r0[1]), lo8_enc(x0[2], r0[2]), lo8_enc(x0[3], r0[3])); lq.y = lo8_pack(lo8_enc(x1[0], r1[0]), lo8_enc(x1[1], r1[1]), lo8_enc(x1[2], r1[2]), lo8_enc(x1[3], r1[3])); *(u32x2*)(lr + c) = lq; }
            s += (x0[0] * x0[0] + x0[1] * x0[1]) + (x0[2] * x0[2] + x0[3] * x0[3]) + (x1[0] * x1[0] + x1[1] * x1[1]) + (x1[2] * x1[2] + x1[3] * x1[3]); }
        s = wave_sum(s); if (lane == 0) ((float*)(ws + WS_SS))[row] = s; }
}

#undef a
__device__ __forceinline__ f32x4 bf4(const u32x2 w) { f32x4 o; o[0] = bf2f(w.x & 0xffffu); o[1] = bf2f(w.x >> 16); o[2] = bf2f(w.y & 0xffffu); o[3] = bf2f(w.y >> 16); return o; }
__device__ __forceinline__ f32x4 hl4(const u32x2 hi, unsigned lo) { f32x4 o = bf4(hi); o[0] += lo8_dec(o[0], lo, 0); o[1] += lo8_dec(o[1], lo, 1); o[2] += lo8_dec(o[2], lo, 2); o[3] += lo8_dec(o[3], lo, 3); return o; }
__device__ __forceinline__ void hgrn_p2(int G, int wv) {
    asm volatile("" : "+s"(wv));
    KArgs ap = kargs();
#define a (*ap)
    bf16_t* U = (bf16_t*)(a.ws + WS_U); const float* DC = (const float*)(a.ws + WS_DC);
    int bid = blockIdx.x; asm volatile("" : "+s"(bid), "+s"(G)); const size_t gt = (size_t)bid * NTHR + TID_FROM_WAVE(wv), GT = (size_t)G * NTHR;
    for (size_t e = gt; e < (size_t)32 * 4096; e += GT) { const int bh = (int)(e >> 12), kv = (int)(e & 4095) * 4, k = kv >> 7; f32x4 S = (f32x4){0.f, 0.f, 0.f, 0.f};
        u32x2 uv[32]; float dcv[32];
#pragma unroll
        for (int c = 0; c < 32; ++c) { uv[c] = *(const u32x2*)(U + ((size_t)(bh * 32 + c) << 14) + kv); dcv[c] = DC[(size_t)(bh * 32 + c) * 128 + k]; }
#pragma unroll
        for (int c = 0; c < 32; ++c) { const size_t idx = ((size_t)(bh * 32 + c) << 14) + kv;
            u32x2 o; o.x = cvt_pk_bf16(S[0], S[1]); o.y = cvt_pk_bf16(S[2], S[3]); *(u32x2*)(U + idx) = o; S = S * dcv[c] + bf4(uv[c]); } }
}
#undef a
#define MFMA16(a, b, c) __builtin_amdgcn_mfma_f32_16x16x32_bf16((a), (b), (c), 0, 0, 0)
__device__ __forceinline__ bf16_t bf1(float x) { return (bf16_t)(cvt_pk_bf16(x, 0.f) & 0xffffu); }
__device__ __forceinline__ void gmlp_unit(LAS unsigned char* lds, int unit, int j, int wv, bool reuse_w) {
    KArgs ap = kargs();
#define a (*ap)
    asm volatile("" : "+s"(wv)); int tid = TID_FROM_WAVE(wv);
    const int lane = tid & 63, fr = lane & 15, fq = lane >> 4;
    unsigned char* ws = a.ws;
    const int g = unit & 7, n = (unit >> 3) & 15, b = unit >> 7; const int row0 = b * SEQ + n * 128, c0 = g * 128;
    const bf16_t* EA = (const bf16_t*)(ws + WS_EA); bf16_t* AB = (bf16_t*)(ws + WS_AB);
    LAS bf16_t* Wt = (LAS bf16_t*)lds; LAS bf16_t* vgT = Wt + 128 * 136;
    u32x2 u2v[8]; float btv[8]; f32x4 g4v[8];
    {   const float* bs = a.in[I_ABS] + ((size_t)j * 8 + g) * 128; const int c = c0 + 16 * wv + 4 * fq; const float* gn = a.in[I_AVN] + (size_t)j * 1024 + c0 + (tid & 3) * 32;
#pragma unroll
        for (int tj = 0; tj < 8; ++tj) { const int t = 16 * tj + fr; btv[tj] = bs[t]; u2v[tj] = *(const u32x2*)(EA + (size_t)(row0 + t) * EIN + c); g4v[tj] = *(const f32x4*)(gn + tj * 4); } }
    if (!reuse_w) {
        const int t = tid >> 2, sq = (tid & 3) * 32; const float* src = a.in[I_AWS] + ((size_t)j * 8 + g) * 128 * 128 + t * 128 + sq;
#pragma unroll
        for (int q = 0; q < 4; ++q) { f32x4 x0 = *(const f32x4*)(src + q * 8), x1 = *(const f32x4*)(src + q * 8 + 4);
#pragma unroll
            for (int e = 0; e < 4; ++e) { if (sq + q * 8 + e > t) x0[e] = 0.f; if (sq + q * 8 + 4 + e > t) x1[e] = 0.f; }
            *(LAS u32x4*)(Wt + t * 136 + sq + q * 8) = pg8::pack8(x0, x1); }
    }
    {
        const int t = tid >> 2, cq = (tid & 3) * 32; const bf16_t* src = EA + (size_t)(row0 + t) * EIN + 1024 + c0 + cq; float x[32]; float s = 0.f;
#pragma unroll
        for (int q = 0; q < 4; ++q) { f32x4 p0, p1; pg8::unpack8(*(const u32x4*)(src + q * 8), p0, p1);
#pragma unroll
            for (int e = 0; e < 4; ++e) { x[q * 8 + e] = p0[e]; x[q * 8 + 4 + e] = p1[e]; s += p0[e] * p0[e] + p1[e] * p1[e]; } }
        s = red4(s); const float rs = __builtin_amdgcn_rsqf(s * (1.0f / 128.0f) + RMS_EPS);
#pragma unroll
        for (int q = 0; q < 8; ++q) { const f32x4 g4 = g4v[q];
#pragma unroll
            for (int e = 0; e < 4; ++e) vgT[(cq + q * 4 + e) * 136 + t] = bf1(x[q * 4 + e] * rs * g4[e]); }
    }
    __syncthreads();
    f32x4 acc[8];
#pragma unroll
    for (int tj = 0; tj < 8; ++tj) acc[tj] = (f32x4){0.f, 0.f, 0.f, 0.f};
#pragma unroll
    for (int ks = 0; ks < 4; ++ks) { const bf16x8 av = *(const LAS bf16x8*)(vgT + (16 * wv + fr) * 136 + 32 * ks + 8 * fq);
#pragma unroll
        for (int tj = 0; tj < 8; ++tj) if (tj >= 2 * ks) { const bf16x8 bv = *(const LAS bf16x8*)(Wt + (16 * tj + fr) * 136 + 32 * ks + 8 * fq); acc[tj] = MFMA16(av, bv, acc[tj]); } }
    {
        const int c = c0 + 16 * wv + 4 * fq;
#pragma unroll
        for (int tj = 0; tj < 8; ++tj) { const int t = 16 * tj + fr; const float bt = btv[tj]; const u32x2 u2 = u2v[tj];
            const float o0 = bf2f(u2.x & 0xffffu) * (acc[tj][0] + bt), o1 = bf2f(u2.x >> 16) * (acc[tj][1] + bt), o2 = bf2f(u2.y & 0xffffu) * (acc[tj][2] + bt), o3 = bf2f(u2.y >> 16) * (acc[tj][3] + bt);
            u32x2 w; w.x = cvt_pk_bf16(o0, o1); w.y = cvt_pk_bf16(o2, o3); *(u32x2*)(AB + (size_t)(row0 + t) * D + c) = w; }
    }
    __syncthreads();
}
#undef a

__device__ __forceinline__ void hgrn_cumsum(LAS float* cum, int tid) {
    __syncthreads();
    {
        LAS float* tot = cum + 137216 / 4; const int k = tid & 127, seg = tid >> 7; float v[16];
#pragma unroll
        for (int i = 0; i < 16; ++i) v[i] = cum[(16 * seg + i) * 136 + k];
#pragma unroll
        for (int i = 1; i < 16; ++i) v[i] += v[i - 1];
        tot[seg * 128 + k] = v[15];
        __syncthreads();
        float off = 0.f;
#pragma unroll
        for (int s2 = 0; s2 < 3; ++s2) if (s2 < seg) off += tot[s2 * 128 + k];
#pragma unroll
        for (int i = 0; i < 16; ++i) cum[(16 * seg + i) * 136 + k] = v[i] + off; }
    __syncthreads();}
__device__ __forceinline__ void hgrn_cum(const float* LOGF, int row0, int h, LAS float* cum, LAS bf16_t* kkb, int tid) {
#pragma unroll
    for (int i = 0; i < 4; ++i) { const int idx = (i * NTHR + tid) * 4; const int t = idx >> 7, k = idx & 127; const f32x4 v = *(const f32x4*)(LOGF + (size_t)(row0 + t) * 1024 + h * 128 + k);
        *(LAS f32x4*)(cum + t * 136 + k) = v;
        if (kkb) { u32x2 o; o.x = cvt_pk_bf16(1.0f - expf_(v[0]), 1.0f - expf_(v[1])); o.y = cvt_pk_bf16(1.0f - expf_(v[2]), 1.0f - expf_(v[3])); *(LAS u32x2*)(kkb + t * 136 + k) = o; } }
    hgrn_cumsum(cum, tid);
}
__device__ __forceinline__ void hgrn_p1_all(LAS unsigned char* lds, int wv) {
    KArgs ap = kargs();
#define a (*ap)
    asm volatile("" : "+s"(wv)); int tid = TID_FROM_WAVE(wv);
    const int lane = tid & 63, fr = lane & 15, fq = lane >> 4;
    unsigned char* ws = a.ws;
    int G = gridDim.x, bid = blockIdx.x; asm volatile("" : "+s"(G), "+s"(bid));
    const bf16_t* EA = (const bf16_t*)(ws + WS_EA); const float* LOGF = (const float*)(ws + WS_LOGF);
    LAS float* cum = (LAS float*)lds;
    LAS bf16_t* qb = (LAS bf16_t*)(lds + 34816);
    LAS bf16_t* kkb = (LAS bf16_t*)(lds + 52224);
    LAS bf16_t* Kd = (LAS bf16_t*)(lds + 69632);
    LAS bf16_t* KdZ = (LAS bf16_t*)(lds + 139264);
    LAS bf16_t* kdT = Kd;
    LAS bf16_t* ivT = (LAS bf16_t*)(lds + 108800);
    LAS bf16_t* att = (LAS bf16_t*)(lds + 127232);
    u32x4 Qv[2], Iv[2]; f32x4 Lv[4];
#define P1_LOAD(unit_) do { const int n_ = (unit_) & 31, h_ = ((unit_) >> 5) & 7, b_ = (unit_) >> 8; const int r0_ = b_ * SEQ + n_ * 64; \
        _Pragma("unroll") for (int i = 0; i < 2; ++i) { const int idx = (i * NTHR + tid) * 8; const bf16_t* p_ = EA + (size_t)(r0_ + (idx >> 7)) * EIN + h_ * 128 + (idx & 127); Qv[i] = *(const u32x4*)(p_ + 2048); Iv[i] = *(const u32x4*)(p_ + 4096); } \
        _Pragma("unroll") for (int i = 0; i < 4; ++i) { const int idx = (i * NTHR + tid) * 4; Lv[i] = *(const f32x4*)(LOGF + (size_t)(r0_ + (idx >> 7)) * 1024 + h_ * 128 + (idx & 127)); } } while (0)
    if (bid < 1024) P1_LOAD(bid);
#pragma unroll 1
    for (int unit = bid; unit < 1024; unit += G) {
    const int n = unit & 31, h = (unit >> 5) & 7, b = unit >> 8; const int row0 = b * SEQ + n * 64;
#pragma unroll
    for (int i = 0; i < 2; ++i) { const int idx = (i * NTHR + tid) * 8; const int t = idx >> 7, k = idx & 127;
        *(LAS u32x4*)(qb + t * 136 + k) = Qv[i];
        const u32x4 w = Iv[i];
        ivT[(k + 0) * 72 + t] = (bf16_t)(w.x & 0xffffu); ivT[(k + 1) * 72 + t] = (bf16_t)(w.x >> 16); ivT[(k + 2) * 72 + t] = (bf16_t)(w.y & 0xffffu); ivT[(k + 3) * 72 + t] = (bf16_t)(w.y >> 16);
        ivT[(k + 4) * 72 + t] = (bf16_t)(w.z & 0xffffu); ivT[(k + 5) * 72 + t] = (bf16_t)(w.z >> 16); ivT[(k + 6) * 72 + t] = (bf16_t)(w.w & 0xffffu); ivT[(k + 7) * 72 + t] = (bf16_t)(w.w >> 16); }
    for (int i = tid; i < 576; i += NTHR) *(LAS u32x4*)((LAS unsigned char*)att + i * 16) = (u32x4){0u, 0u, 0u, 0u};
#pragma unroll
    for (int i = 0; i < 4; ++i) { const int idx = (i * NTHR + tid) * 4; const int t = idx >> 7, k = idx & 127; const f32x4 v = Lv[i];
        *(LAS f32x4*)(cum + t * 136 + k) = v;
        u32x2 o; o.x = cvt_pk_bf16(1.0f - expf_(v[0]), 1.0f - expf_(v[1])); o.y = cvt_pk_bf16(1.0f - expf_(v[2]), 1.0f - expf_(v[3])); *(LAS u32x2*)(kkb + t * 136 + k) = o; }
    if (unit + G < 1024) P1_LOAD(unit + G);
    hgrn_cumsum(cum, tid);
#pragma unroll
    for (int i = 0; i < 4; ++i) { const int idx = i * NTHR + tid; const int t = idx >> 5, k = (idx & 31) * 4; const int I = t >> 4;
        const f32x4 ct = *(const LAS f32x4*)(cum + t * 136 + k); f32x4 cI = (f32x4){0.f, 0.f, 0.f, 0.f}; if (I > 0) cI = *(const LAS f32x4*)(cum + (16 * I - 1) * 136 + k);
        const u32x2 q2 = *(const LAS u32x2*)(qb + t * 136 + k);
        u32x2 o; o.x = cvt_pk_bf16(bf2f(q2.x & 0xffffu) * expf_(ct[0] - cI[0]), bf2f(q2.x >> 16) * expf_(ct[1] - cI[1])); o.y = cvt_pk_bf16(bf2f(q2.y & 0xffffu) * expf_(ct[2] - cI[2]), bf2f(q2.y >> 16) * expf_(ct[3] - cI[3]));
        *(LAS u32x2*)(qb + t * 136 + k) = o; }
#pragma unroll
    for (int i = 0; i < 10; ++i) { const int idx = i * NTHR + tid; const int rr = idx >> 5, k = (idx & 31) * 4; const int I = rr < 16 ? 0 : (rr < 48 ? 1 : (rr < 96 ? 2 : 3)); const int sidx = rr - (I == 0 ? 0 : (I == 1 ? 16 : (I == 2 ? 48 : 96)));
        const f32x4 cs = *(const LAS f32x4*)(cum + sidx * 136 + k); f32x4 cI = (f32x4){0.f, 0.f, 0.f, 0.f}; if (I > 0) cI = *(const LAS f32x4*)(cum + (16 * I - 1) * 136 + k);
        const u32x2 k2 = *(const LAS u32x2*)(kkb + sidx * 136 + k);
        u32x2 o; o.x = cvt_pk_bf16(bf2f(k2.x & 0xffffu) * expf_(fminf(cI[0] - cs[0], 80.f)), bf2f(k2.x >> 16) * expf_(fminf(cI[1] - cs[1], 80.f))); o.y = cvt_pk_bf16(bf2f(k2.y & 0xffffu) * expf_(fminf(cI[2] - cs[2], 80.f)), bf2f(k2.y >> 16) * expf_(fminf(cI[3] - cs[3], 80.f)));
        LAS bf16_t* dst = I == 0 ? KdZ + sidx * 136 + k : Kd + (rr - 16) * 136 + k; *(LAS u32x2*)dst = o; }
    __syncthreads();
    for (int tile = wv; tile < 10; tile += 8) { const int I = tile == 0 ? 0 : (tile < 3 ? 1 : (tile < 6 ? 2 : 3)); const int J = tile - (I == 0 ? 0 : (I == 1 ? 1 : (I == 2 ? 3 : 6)));
        const LAS bf16_t* kb = I == 0 ? KdZ : Kd + (I == 1 ? 0 : (I == 2 ? 32 : 80)) * 136;
        f32x4 c = (f32x4){0.f, 0.f, 0.f, 0.f};
#pragma unroll
        for (int ks = 0; ks < 4; ++ks) c = MFMA16(*(const LAS bf16x8*)(qb + (16 * I + fr) * 136 + 32 * ks + 8 * fq), *(const LAS bf16x8*)(kb + (16 * J + fr) * 136 + 32 * ks + 8 * fq), c);
#pragma unroll
        for (int r = 0; r < 4; ++r) att[(16 * I + 4 * fq + r) * 72 + 16 * J + fr] = bf1((J < I || fr <= 4 * fq + r) ? c[r] : 0.f); }
    __syncthreads();
    {
        f32x4 acc[4];
#pragma unroll
        for (int I = 0; I < 4; ++I) acc[I] = (f32x4){0.f, 0.f, 0.f, 0.f};
#pragma unroll
        for (int ks = 0; ks < 2; ++ks) { const bf16x8 av = *(const LAS bf16x8*)(ivT + (16 * wv + fr) * 72 + 32 * ks + 8 * fq);
#pragma unroll
            for (int I = 0; I < 4; ++I) if (32 * ks <= 16 * I + 15) acc[I] = MFMA16(av, *(const LAS bf16x8*)(att + (16 * I + fr) * 72 + 32 * ks + 8 * fq), acc[I]); }
        float* OI = (float*)(ws + WS_OI);
#pragma unroll
        for (int I = 0; I < 4; ++I) *(f32x4*)(OI + (size_t)(row0 + 16 * I + fr) * 1024 + h * 128 + 16 * wv + 4 * fq) = acc[I];
#pragma unroll
        for (int i = 0; i < 4; ++i) { const int idx = (i * NTHR + tid) * 4; const int sidx = idx >> 7, k = idx & 127; const f32x4 cs = *(const LAS f32x4*)(cum + sidx * 136 + k), cl = *(const LAS f32x4*)(cum + 63 * 136 + k); const u32x2 k2 = *(const LAS u32x2*)(kkb + sidx * 136 + k);
            kdT[(k + 0) * 72 + sidx] = bf1(bf2f(k2.x & 0xffffu) * expf_(cl[0] - cs[0])); kdT[(k + 1) * 72 + sidx] = bf1(bf2f(k2.x >> 16) * expf_(cl[1] - cs[1]));
            kdT[(k + 2) * 72 + sidx] = bf1(bf2f(k2.y & 0xffffu) * expf_(cl[2] - cs[2])); kdT[(k + 3) * 72 + sidx] = bf1(bf2f(k2.y >> 16) * expf_(cl[3] - cs[3])); }
    }
    __syncthreads();
    {
        f32x4 acc[8];
#pragma unroll
        for (int kt = 0; kt < 8; ++kt) acc[kt] = (f32x4){0.f, 0.f, 0.f, 0.f};
#pragma unroll
        for (int ks = 0; ks < 2; ++ks) { const bf16x8 av = *(const LAS bf16x8*)(ivT + (16 * wv + fr) * 72 + 32 * ks + 8 * fq);
#pragma unroll
            for (int kt = 0; kt < 8; ++kt) acc[kt] = MFMA16(av, *(const LAS bf16x8*)(kdT + (16 * kt + fr) * 72 + 32 * ks + 8 * fq), acc[kt]); }
        bf16_t* U = (bf16_t*)(ws + WS_U) + (size_t)unit * 16384;
#pragma unroll
        for (int kt = 0; kt < 8; ++kt) { u32x2 o; o.x = cvt_pk_bf16(acc[kt][0], acc[kt][1]); o.y = cvt_pk_bf16(acc[kt][2], acc[kt][3]); *(u32x2*)(U + (16 * kt + fr) * 128 + 16 * wv + 4 * fq) = o; }
        if (tid < 128) ((float*)(ws + WS_DC))[(size_t)unit * 128 + tid] = expf_(cum[63 * 136 + tid]);
    }
    __syncthreads();
    }
#undef P1_LOAD
}
#undef a
__device__ __forceinline__ void hgrn_p3_all(LAS unsigned char* lds, int j, int wv) {
    KArgs ap = kargs();
#define a (*ap)
    asm volatile("" : "+s"(wv)); int tid = TID_FROM_WAVE(wv);
    const int lane = tid & 63, fr = lane & 15, fq = lane >> 4;
    unsigned char* ws = a.ws;
    int G = gridDim.x, bid = blockIdx.x; asm volatile("" : "+s"(G), "+s"(bid));
    const bf16_t* EA = (const bf16_t*)(ws + WS_EA); const float* LOGF = (const float*)(ws + WS_LOGF); const float* OI = (const float*)(ws + WS_OI);
    LAS float* cum = (LAS float*)lds;
    LAS bf16_t* qd = (LAS bf16_t*)(lds + 34816);
    LAS bf16_t* SpT = (LAS bf16_t*)(lds + 52224);
    LAS float* part = (LAS float*)(lds + 87040);
    f32x4 Lv[4], Ov[4], on; u32x4 Uv[4], Qv[2]; u32x2 Gv[4];
#define P3_LOAD_A(unit_) do { const int n_ = (unit_) & 31, h_ = ((unit_) >> 5) & 7, b_ = (unit_) >> 8; const int r0_ = b_ * SEQ + n_ * 64; const bf16_t* U_ = (const bf16_t*)(ws + WS_U) + (size_t)(unit_) * 16384; \
        _Pragma("unroll") for (int i = 0; i < 4; ++i) Uv[i] = *(const u32x4*)(U_ + (i * NTHR + tid) * 8); \
        _Pragma("unroll") for (int i = 0; i < 4; ++i) { const int idx = (i * NTHR + tid) * 4; Lv[i] = *(const f32x4*)(LOGF + (size_t)(r0_ + (idx >> 7)) * 1024 + h_ * 128 + (idx & 127)); } \
        _Pragma("unroll") for (int i = 0; i < 2; ++i) { const int idx = (i * NTHR + tid) * 8; Qv[i] = *(const u32x4*)(EA + (size_t)(r0_ + (idx >> 7)) * EIN + 2048 + h_ * 128 + (idx & 127)); } } while (0)
#define P3_LOAD_B(unit_) do { const int n_ = (unit_) & 31, h_ = ((unit_) >> 5) & 7, b_ = (unit_) >> 8; const int r0_ = b_ * SEQ + n_ * 64; const int vc_ = h_ * 128 + 16 * wv + 4 * fq; \
        _Pragma("unroll") for (int tt = 0; tt < 4; ++tt) { Ov[tt] = *(const f32x4*)(OI + (size_t)(r0_ + 16 * tt + fr) * 1024 + vc_); Gv[tt] = *(const u32x2*)(EA + (size_t)(r0_ + 16 * tt + fr) * EIN + 5120 + vc_); } \
        on = *(const f32x4*)(a.in[I_BON] + (size_t)j * 1024 + vc_); } while (0)
    if (bid < 1024) { P3_LOAD_A(bid); P3_LOAD_B(bid); }
#pragma unroll 1
    for (int unit = bid; unit < 1024; unit += G) {
        const int n = unit & 31, h = (unit >> 5) & 7, b = unit >> 8; const int row0 = b * SEQ + n * 64; const bool more = unit + G < 1024;
#pragma unroll
        for (int i = 0; i < 4; ++i) { const int idx = (i * NTHR + tid) * 8; const int k = idx >> 7, v = idx & 127; const u32x4 x = Uv[i];
            SpT[(v + 0) * 136 + k] = (bf16_t)(x.x & 0xffffu); SpT[(v + 1) * 136 + k] = (bf16_t)(x.x >> 16); SpT[(v + 2) * 136 + k] = (bf16_t)(x.y & 0xffffu); SpT[(v + 3) * 136 + k] = (bf16_t)(x.y >> 16);
            SpT[(v + 4) * 136 + k] = (bf16_t)(x.z & 0xffffu); SpT[(v + 5) * 136 + k] = (bf16_t)(x.z >> 16); SpT[(v + 6) * 136 + k] = (bf16_t)(x.w & 0xffffu); SpT[(v + 7) * 136 + k] = (bf16_t)(x.w >> 16); }
#pragma unroll
        for (int i = 0; i < 4; ++i) { const int idx = (i * NTHR + tid) * 4; *(LAS f32x4*)(cum + (idx >> 7) * 136 + (idx & 127)) = Lv[i]; }
        hgrn_cumsum(cum, tid);
#pragma unroll
        for (int i = 0; i < 2; ++i) { const int idx = (i * NTHR + tid) * 8; const int t = idx >> 7, k = idx & 127; f32x4 p0, p1;
            pg8::unpack8(Qv[i], p0, p1);
            const f32x4 c0 = *(const LAS f32x4*)(cum + t * 136 + k), c1 = *(const LAS f32x4*)(cum + t * 136 + k + 4);
#pragma unroll
            for (int q = 0; q < 4; ++q) { p0[q] *= expf_(c0[q]); p1[q] *= expf_(c1[q]); }
            *(LAS u32x4*)(qd + t * 136 + k) = pg8::pack8(p0, p1); }
        if (more) P3_LOAD_A(unit + G);
        __syncthreads();
        f32x4 acc[4];
#pragma unroll
        for (int tt = 0; tt < 4; ++tt) acc[tt] = (f32x4){0.f, 0.f, 0.f, 0.f};
#pragma unroll
        for (int ks = 0; ks < 4; ++ks) { const bf16x8 av = *(const LAS bf16x8*)(SpT + (16 * wv + fr) * 136 + 32 * ks + 8 * fq);
#pragma unroll
            for (int tt = 0; tt < 4; ++tt) acc[tt] = MFMA16(av, *(const LAS bf16x8*)(qd + (16 * tt + fr) * 136 + 32 * ks + 8 * fq), acc[tt]); }
        const int vcol = h * 128 + 16 * wv + 4 * fq;
#pragma unroll
        for (int tt = 0; tt < 4; ++tt) { acc[tt] += Ov[tt];
            float sq = (acc[tt][0] * acc[tt][0] + acc[tt][1] * acc[tt][1]) + (acc[tt][2] * acc[tt][2] + acc[tt][3] * acc[tt][3]); sq += shfl_xor_f(sq, 16); sq += shfl_xor_f(sq, 32);
            if (fq == 0) part[wv * 64 + 16 * tt + fr] = sq; }
        __syncthreads();
#pragma unroll
        for (int tt = 0; tt < 4; ++tt) { const int t = 16 * tt + fr; float sq = 0.f;
#pragma unroll
            for (int w8 = 0; w8 < 8; ++w8) sq += part[w8 * 64 + t];
            const float rs = __builtin_amdgcn_rsqf(sq * (1.0f / 128.0f) + RMS_EPS);
            const u32x2 g2 = Gv[tt];
            u32x2 w; w.x = cvt_pk_bf16(acc[tt][0] * rs * on[0] * bf2f(g2.x & 0xffffu), acc[tt][1] * rs * on[1] * bf2f(g2.x >> 16)); w.y = cvt_pk_bf16(acc[tt][2] * rs * on[2] * bf2f(g2.y & 0xffffu), acc[tt][3] * rs * on[3] * bf2f(g2.y >> 16));
            *(u32x2*)((bf16_t*)(ws + WS_AB) + (size_t)(row0 + t) * D + 1024 + vcol) = w; }
        if (more) P3_LOAD_B(unit + G);
        __syncthreads();
    }
#undef P3_LOAD_A
#undef P3_LOAD_B
}
#undef a

__device__ __forceinline__ void rwkv_mix(int G, int L, int j, int wv) {
    KArgs ap = kargs();
#define a (*ap)
    asm volatile("" : "+s"(wv)); int tid = TID_FROM_WAVE(wv);
    const int lane = tid & 63, wave = wv;
    unsigned char* ws = a.ws; const bf16_t* h = (const bf16_t*)(ws + WS_HB0); const unsigned char* lo8 = ws + WS_H; const float* ss = (const float*)(ws + WS_SS) + (size_t)(4 * L + 1) * M;
    const float* gn = a.in[I_NORMS] + (size_t)(4 * L + 1) * D; const float* mix = a.in[I_CMIX] + (size_t)j * 6 * D; bf16_t* XM = (bf16_t*)(ws + WS_XM);
    int bid = blockIdx.x; asm volatile("" : "+s"(bid), "+s"(G)); const int gw = bid * NWAVES + wave, NGW = G * NWAVES;
    for (int row0 = gw * 4; row0 < M; row0 += NGW * 4) { const int t0 = row0 & (SEQ - 1);
        float rsv[5]; rsv[0] = t0 > 0 ? rstd_of(ss[row0 - 1]) : 0.f;
#pragma unroll
        for (int r = 0; r < 4; ++r) rsv[r + 1] = rstd_of(ss[row0 + r]);
        const bf16_t* hp = h + (size_t)(t0 > 0 ? row0 - 1 : row0) * D; const bf16_t* h0 = h + (size_t)row0 * D;
        u32x2 xr[2][5]; unsigned xl[2][5]; f32x4 cf[2][7]; const unsigned char* lp = lo8 + (size_t)(t0 > 0 ? row0 - 1 : row0) * D; const unsigned char* l0 = lo8 + (size_t)row0 * D;
#define MIX_LOAD(bf, q) do { const int c_ = ((q) * 64 + lane) * 4; xr[bf][0] = *(const u32x2*)(hp + c_); xl[bf][0] = *(const unsigned*)(lp + c_); _Pragma("unroll") for (int r = 0; r < 4; ++r) { xr[bf][r + 1] = *(const u32x2*)(h0 + (size_t)r * D + c_); xl[bf][r + 1] = *(const unsigned*)(l0 + (size_t)r * D + c_); } \
            cf[bf][0] = *(const f32x4*)(gn + c_); _Pragma("unroll") for (int s = 0; s < 6; ++s) cf[bf][s + 1] = *(const f32x4*)(mix + (size_t)s * D + c_); } while (0)
#define MIX_DO(bf, q) do { const int c = ((q) * 64 + lane) * 4; f32x4 xp = hl4(xr[bf][0], xl[bf][0]) * rsv[0] * cf[bf][0]; \
            _Pragma("unroll") for (int r = 0; r < 4; ++r) { const f32x4 x = hl4(xr[bf][r + 1], xl[bf][r + 1]) * rsv[r + 1] * cf[bf][0]; const f32x4 xx = xp - x; \
                _Pragma("unroll") for (int s = 0; s < 6; ++s) { const int slot = s == 0 ? 0 : (s == 1 ? 3 : (s == 2 ? 1 : (s == 3 ? 2 : s))); const f32x4 o = x + xx * cf[bf][s + 1]; \
                    u32x2 w; w.x = cvt_pk_bf16(o[0], o[1]); w.y = cvt_pk_bf16(o[2], o[3]); *(u32x2*)(XM + ((size_t)slot * M + row0 + r) * D + c) = w; } \
                xp = x; } } while (0)
        MIX_LOAD(0, 0);
#pragma unroll 1
        for (int q = 0; q < 8; q += 2) { MIX_LOAD(1, q + 1); MIX_DO(0, q); if (q + 2 < 8) MIX_LOAD(0, q + 2); MIX_DO(1, q + 1); }
#undef MIX_DO
#undef MIX_LOAD
    }
}
#undef a
constexpr int TC = 32;
struct ScanRaw { u32x2 r, k, v, e, av, g, f, vg; };
__device__ __forceinline__ void rwkv_scan_unit(LAS unsigned char* lds, int unit, int j, int wv) {
    KArgs ap = kargs();
#define a (*ap)
    asm volatile("" : "+s"(wv)); int tid = TID_FROM_WAVE(wv);
    unsigned char* ws = a.ws;
    const int hd = unit & 31, b = unit >> 5; const int cbase = hd * 64;
    const bf16_t* Rb = (const bf16_t*)(ws + WS_RKV); const bf16_t* Kb = Rb + (size_t)M * D; const bf16_t* Vb = j == 0 ? (const bf16_t*)(ws + WS_VF) : Rb + (size_t)2 * M * D;
    const bf16_t* VF = (const bf16_t*)(ws + WS_VF);
    const bf16_t* EW = (const bf16_t*)(ws + WS_WAGV); const bf16_t* Ab = EW + (size_t)M * D; const bf16_t* Gb = EW + (size_t)2 * M * D; const bf16_t* VG = EW + (size_t)3 * M * D;
    bf16_t* Y = (bf16_t*)(ws + WS_Y);
    constexpr int ARR = TC * 64, BUFW = 7 * ARR + 64;
    LAS float* L0 = (LAS float*)lds; LAS float* L_y = L0 + 2 * BUFW;
    const int pt = tid >> 4, pc = (tid & 15) * 4;
    const int sp = tid >> 4, sq = (tid & 15) * 4;
    const f32x4 kk4 = *(const f32x4*)(a.in[I_CKK] + (size_t)j * D + cbase + pc), ka4 = *(const f32x4*)(a.in[I_CKA] + (size_t)j * D + cbase + pc), rk4 = *(const f32x4*)(a.in[I_CRK] + (size_t)j * D + cbase + pc);
    const f32x4 gg4 = *(const f32x4*)(a.in[I_CGNG] + (size_t)j * D + cbase + pc), gb4 = *(const f32x4*)(a.in[I_CGNB] + (size_t)j * D + cbase + pc);
    const size_t grow0 = (size_t)(b * SEQ + pt) * D + cbase + pc;
#define SCAN_FETCH(raw, t0) do { const size_t gr_ = grow0 + (size_t)(t0) * D; (raw).r = *(const u32x2*)(Rb + gr_); (raw).k = *(const u32x2*)(Kb + gr_); (raw).v = *(const u32x2*)(Vb + gr_); (raw).e = *(const u32x2*)(EW + gr_); \
        (raw).av = *(const u32x2*)(Ab + gr_); (raw).g = *(const u32x2*)(Gb + gr_); if (j == 1) { (raw).f = *(const u32x2*)(VF + gr_); (raw).vg = *(const u32x2*)(VG + gr_); } } while (0)
#define SCAN_PREP(raw, Lb) do { const f32x4 r_ = bf4((raw).r), k_ = bf4((raw).k), ew_ = bf4((raw).e), aa_ = bf4((raw).av); f32x4 v_ = bf4((raw).v); \
        if (j == 1) { const f32x4 vf_ = bf4((raw).f), vg_ = bf4((raw).vg); v_ = v_ + (vf_ - v_) * vg_; } \
        f32x4 kk_ = k_ * kk4; float n2_ = (kk_[0] * kk_[0] + kk_[1] * kk_[1]) + (kk_[2] * kk_[2] + kk_[3] * kk_[3]); n2_ = red16(n2_); \
        kk_ = kk_ * (1.0f / fmaxf(sqrtf(n2_), 1e-12f)); const f32x4 km_ = k_ * (1.0f + (aa_ - 1.0f) * ka4); \
        f32x4 w_; w_[0] = expf_(-ew_[0]); w_[1] = expf_(-ew_[1]); w_[2] = expf_(-ew_[2]); w_[3] = expf_(-ew_[3]); \
        float bon_ = (r_[0] * km_[0] * rk4[0] + r_[1] * km_[1] * rk4[1]) + (r_[2] * km_[2] * rk4[2] + r_[3] * km_[3] * rk4[3]); bon_ = red16(bon_); \
        const int li_ = pt * 64 + pc; *(LAS f32x4*)((Lb) + li_) = r_; *(LAS f32x4*)((Lb) + ARR + li_) = w_; *(LAS f32x4*)((Lb) + 2 * ARR + li_) = km_; *(LAS f32x4*)((Lb) + 3 * ARR + li_) = v_; \
        *(LAS f32x4*)((Lb) + 4 * ARR + li_) = -kk_; *(LAS f32x4*)((Lb) + 5 * ARR + li_) = kk_ * aa_; *(LAS f32x4*)((Lb) + 6 * ARR + li_) = bf4((raw).g); if ((tid & 15) == 0) (Lb)[7 * ARR + pt] = bon_; } while (0)
    ScanRaw raw; raw.f = (u32x2){0u, 0u}; raw.vg = raw.f;
    SCAN_FETCH(raw, 0); SCAN_PREP(raw, L0);
    __syncthreads();
    f32x2 S0a = {0.f, 0.f}, S0b = S0a, S1a = S0a, S1b = S0a;
    for (int c = 0; c < SEQ / TC; ++c) {
        LAS float* Lc = L0 + (c & 1) * BUFW; LAS float* Ln = L0 + ((c + 1) & 1) * BUFW;
        const bool more = (c + 1) < SEQ / TC;
        if (more) SCAN_FETCH(raw, (c + 1) * TC);
        {
            f32x4 rr = *(const LAS f32x4*)(Lc + sq), ww = *(const LAS f32x4*)(Lc + ARR + sq), kx = *(const LAS f32x4*)(Lc + 2 * ARR + sq), an = *(const LAS f32x4*)(Lc + 4 * ARR + sq), bb = *(const LAS f32x4*)(Lc + 5 * ARR + sq);
            float v0 = Lc[3 * ARR + sp], v1 = Lc[3 * ARR + sp + 32];
            for (int tb = 0; tb < TC / 16; ++tb) { float yk0 = 0.f, yk1 = 0.f;
#pragma unroll
                for (int ti = 0; ti < 16; ++ti) { const int t = tb * 16 + ti; const int tn = (t + 1 < TC) ? t + 1 : t; const int lo = tn * 64 + sq;
                    const f32x4 rr_n = *(const LAS f32x4*)(Lc + lo), ww_n = *(const LAS f32x4*)(Lc + ARR + lo), kx_n = *(const LAS f32x4*)(Lc + 2 * ARR + lo), an_n = *(const LAS f32x4*)(Lc + 4 * ARR + lo), bb_n = *(const LAS f32x4*)(Lc + 5 * ARR + lo);
                    const float v0_n = Lc[3 * ARR + tn * 64 + sp], v1_n = Lc[3 * ARR + tn * 64 + sp + 32];
                    const f32x2 an0 = {an[0], an[1]}, an1 = {an[2], an[3]}, w0 = {ww[0], ww[1]}, w1 = {ww[2], ww[3]}, k0 = {kx[0], kx[1]}, k1 = {kx[2], kx[3]}, b0 = {bb[0], bb[1]}, b1 = {bb[2], bb[3]}, r0 = {rr[0], rr[1]}, r1 = {rr[2], rr[3]};
                    const f32x2 p0 = S0a * an0 + S0b * an1, p1 = S1a * an0 + S1b * an1;
                    const float sa0 = red16(p0.x + p0.y), sa1 = red16(p1.x + p1.y);
                    const f32x2 sa0v = {sa0, sa0}, sa1v = {sa1, sa1}, v0v = {v0, v0}, v1v = {v1, v1};
                    S0a = S0a * w0 + (v0v * k0 + sa0v * b0); S0b = S0b * w1 + (v0v * k1 + sa0v * b1);
                    S1a = S1a * w0 + (v1v * k0 + sa1v * b0); S1b = S1b * w1 + (v1v * k1 + sa1v * b1);
                    const f32x2 q0 = S0a * r0 + S0b * r1, q1 = S1a * r0 + S1b * r1;
                    const float y0 = red16(q0.x + q0.y), y1 = red16(q1.x + q1.y);
                    const bool mine = (tid & 15) == ti; yk0 = mine ? y0 : yk0; yk1 = mine ? y1 : yk1;
                    rr = rr_n; ww = ww_n; kx = kx_n; an = an_n; bb = bb_n; v0 = v0_n; v1 = v1_n; }
                L_y[(tb * 16 + (tid & 15)) * 64 + sp] = yk0; L_y[(tb * 16 + (tid & 15)) * 64 + sp + 32] = yk1; }
        }
        __syncthreads();
        {
            const int li = pt * 64 + pc; const f32x4 y = *(const LAS f32x4*)(L_y + li), v = *(const LAS f32x4*)(Lc + 3 * ARR + li), gg = *(const LAS f32x4*)(Lc + 6 * ARR + li);
            float s1 = (y[0] + y[1]) + (y[2] + y[3]); s1 = red16(s1); const float mu = s1 * (1.0f / 64.0f);
            const f32x4 d = y - mu; float q = (d[0] * d[0] + d[1] * d[1]) + (d[2] * d[2] + d[3] * d[3]); q = red16(q);
            const float rs = __builtin_amdgcn_rsqf(q * (1.0f / 64.0f) + GN_EPS); const float bon = Lc[7 * ARR + pt];
            const f32x4 o = (d * rs * gg4 + gb4 + bon * v) * gg;
            u32x2 wv2; wv2.x = cvt_pk_bf16(o[0], o[1]); wv2.y = cvt_pk_bf16(o[2], o[3]); *(u32x2*)(Y + grow0 + (size_t)(c * TC) * D) = wv2;
        }
        if (more) SCAN_PREP(raw, Ln);
        __syncthreads();
    }
#undef SCAN_FETCH
#undef SCAN_PREP
}
#undef a
typedef __attribute__((address_space(1))) unsigned long long gu64_t;
__device__ __forceinline__ void rwkv_scan_split(LAS unsigned char* lds, int head, int half, int j, int wv, int cv_lo, int cv_hi) {
    KArgs ap = kargs();
#define a (*ap)
    asm volatile("" : "+s"(wv)); const int lane = lane_id(); const int tid = wv * 64 + lane;
    unsigned char* ws = a.ws;
    const int hd = head & 31, b = head >> 5; const int cbase = hd * 64, own = 32 * half;
    constexpr int NCH = SEQ / TC;
    LAS float* OPB = (LAS float*)lds; LAS float* VB = OPB + 2 * 5 * 2048; LAS float* FG = VB + 4 * 1024; LAS float* YB = FG + 4 * 1024; LAS float* FB = YB + 3 * 1024; LAS float* ST = FB + 4 * 32;
    gu64_t* XG = (gu64_t*)(ws + WS_XG); gu64_t* xg_mine = XG + (size_t)((head * 2 + half) * NCH) * 64; gu64_t* xg_peer = XG + (size_t)((head * 2 + (half ^ 1)) * NCH) * 64;
    const bool is_s = wv < 4; const int ht = tid - 256; const int hgw = (head * 2 + half) * 4 + (wv - 4);
    const int tagbase = (j + 1) << 10;
    const int pt = (ht >> 3) & 31, c8 = (ht & 7) * 8;
    const int r4 = (ht & 7) * 4;
    const size_t grow0 = (size_t)(b * SEQ + pt) * D + cbase + c8;
    const bf16_t* Rb = (const bf16_t*)(ws + WS_RKV); const bf16_t* Kb = Rb + (size_t)M * D; const bf16_t* Vb = j == 0 ? (const bf16_t*)(ws + WS_VF) : Rb + (size_t)2 * M * D; const bf16_t* VF = (const bf16_t*)(ws + WS_VF);
    const bf16_t* EW = (const bf16_t*)(ws + WS_WAGV); const bf16_t* Ab = EW + (size_t)M * D; const bf16_t* Gb = EW + (size_t)2 * M * D; const bf16_t* VG = EW + (size_t)3 * M * D;
    bf16_t* Y = (bf16_t*)(ws + WS_Y);
    u32x4 rw_r, rw_k, rw_v, rw_e, rw_a, rw_g, rw_f, rw_vg; rw_f = (u32x4){0u, 0u, 0u, 0u}; rw_vg = rw_f; rw_r = rw_f; rw_k = rw_f; rw_v = rw_f; rw_e = rw_f; rw_a = rw_f; rw_g = rw_f;
#define SP_FETCH(cn) do { const size_t gr_ = grow0 + (size_t)((cn) * TC) * D; rw_r = *(const u32x4*)(Rb + gr_); rw_k = *(const u32x4*)(Kb + gr_); rw_v = *(const u32x4*)(Vb + gr_); rw_e = *(const u32x4*)(EW + gr_); \
        rw_a = *(const u32x4*)(Ab + gr_); rw_g = *(const u32x4*)(Gb + gr_); if (j == 1) { rw_f = *(const u32x4*)(VF + gr_); rw_vg = *(const u32x4*)(VG + gr_); } } while (0)
#define SP_PREP(cn) do { f32x4 r0_, r1_, k0_, k1_, v0_, v1_, e0_, e1_, a0_, a1_, g0_, g1_; pg8::unpack8(rw_r, r0_, r1_); pg8::unpack8(rw_k, k0_, k1_); pg8::unpack8(rw_v, v0_, v1_); pg8::unpack8(rw_e, e0_, e1_); pg8::unpack8(rw_a, a0_, a1_); pg8::unpack8(rw_g, g0_, g1_); \
        if (j == 1) { f32x4 f0_, f1_, m0_, m1_; pg8::unpack8(rw_f, f0_, f1_); pg8::unpack8(rw_vg, m0_, m1_); v0_ = v0_ + (f0_ - v0_) * m0_; v1_ = v1_ + (f1_ - v1_) * m1_; } \
        const f32x4 kkw0_ = *(const f32x4*)(a.in[I_CKK] + (size_t)j * D + cbase + c8), kkw1_ = *(const f32x4*)(a.in[I_CKK] + (size_t)j * D + cbase + c8 + 4), kaw0_ = *(const f32x4*)(a.in[I_CKA] + (size_t)j * D + cbase + c8), kaw1_ = *(const f32x4*)(a.in[I_CKA] + (size_t)j * D + cbase + c8 + 4); \
        const f32x4 rkw0_ = *(const f32x4*)(a.in[I_CRK] + (size_t)j * D + cbase + c8), rkw1_ = *(const f32x4*)(a.in[I_CRK] + (size_t)j * D + cbase + c8 + 4); \
        f32x4 q0_ = k0_ * kkw0_, q1_ = k1_ * kkw1_; float n2_ = (q0_[0] * q0_[0] + q0_[1] * q0_[1]) + (q0_[2] * q0_[2] + q0_[3] * q0_[3]) + (q1_[0] * q1_[0] + q1_[1] * q1_[1]) + (q1_[2] * q1_[2] + q1_[3] * q1_[3]); n2_ = red8(n2_); \
        const float inv_ = 1.0f / fmaxf(sqrtf(n2_), 1e-12f); q0_ = q0_ * inv_; q1_ = q1_ * inv_; const f32x4 km0_ = k0_ * (1.0f + (a0_ - 1.0f) * kaw0_), km1_ = k1_ * (1.0f + (a1_ - 1.0f) * kaw1_); \
        f32x4 w0_, w1_; for (int e_ = 0; e_ < 4; ++e_) { w0_[e_] = expf_(-e0_[e_]); w1_[e_] = expf_(-e1_[e_]); } \
        float bon_ = (r0_[0] * km0_[0] * rkw0_[0] + r0_[1] * km0_[1] * rkw0_[1]) + (r0_[2] * km0_[2] * rkw0_[2] + r0_[3] * km0_[3] * rkw0_[3]) + (r1_[0] * km1_[0] * rkw1_[0] + r1_[1] * km1_[1] * rkw1_[1]) + (r1_[2] * km1_[2] * rkw1_[2] + r1_[3] * km1_[3] * rkw1_[3]); bon_ = red8(bon_); \
        LAS float* ob_ = OPB + ((cn) & 1) * 10240 + pt * 64 + c8; *(LAS f32x4*)(ob_) = r0_; *(LAS f32x4*)(ob_ + 4) = r1_; *(LAS f32x4*)(ob_ + 2048) = w0_; *(LAS f32x4*)(ob_ + 2052) = w1_; *(LAS f32x4*)(ob_ + 4096) = km0_; *(LAS f32x4*)(ob_ + 4100) = km1_; \
        *(LAS f32x4*)(ob_ + 6144) = -q0_; *(LAS f32x4*)(ob_ + 6148) = -q1_; *(LAS f32x4*)(ob_ + 8192) = q0_ * a0_; *(LAS f32x4*)(ob_ + 8196) = q1_ * a1_; \
        if ((c8 >> 5) == half) { const int o_ = ((cn) & 3) * 1024 + pt * 32 + (c8 & 31); *(LAS f32x4*)(VB + o_) = v0_; *(LAS f32x4*)(VB + o_ + 4) = v1_; *(LAS f32x4*)(FG + o_) = g0_; *(LAS f32x4*)(FG + o_ + 4) = g1_; } \
        if ((ht & 7) == 0) FB[((cn) & 3) * 32 + pt] = bon_; } while (0)
    if (!is_s) { SP_FETCH(0); SP_PREP(0); }
    __syncthreads();
    const int sp = (tid >> 4) & 15, sq = (tid & 15) * 4;
    f32x2 S0a = {0.f, 0.f}, S0b = S0a, S1a = S0a, S1b = S0a;
    const int cv_per = (cv_hi - cv_lo + 1023) / 1024; int cv_it = cv_lo + hgw * cv_per; const int cv_end = (cv_it + cv_per < cv_hi) ? cv_it + cv_per : cv_hi; bool cv_on = !is_s && cv_it < cv_end;
    TrDesc cvd; f32x4 cvx[2][4]; f32x4 cvx1[1][4];
    if (cv_on) { cvd = tr_decode(cv_it); if (cvd.nc == 2) tr_load<2>(cvd.W, cvd.N, cvd.k0, cvd.n0, cvx, lane); else tr_load<1>(cvd.W, cvd.N, cvd.k0, cvd.n0, cvx1, lane); }
    if (is_s) __builtin_amdgcn_s_setprio(2);
    for (int c = 0; c < NCH + 2; ++c) {
        if (is_s) {
            if (c < NCH) {
                LAS float* Lc = OPB + (c & 1) * 10240; LAS float* Lv = VB + (c & 3) * 1024; LAS float* Ly = YB + (c % 3) * 1024;
                f32x4 rr = *(const LAS f32x4*)(Lc + sq), ww = *(const LAS f32x4*)(Lc + 2048 + sq), kx = *(const LAS f32x4*)(Lc + 4096 + sq), an = *(const LAS f32x4*)(Lc + 6144 + sq), bb = *(const LAS f32x4*)(Lc + 8192 + sq);
                float v0 = Lv[sp], v1 = Lv[sp + 16];
                for (int tb = 0; tb < TC / 16; ++tb) { float py0[16], py1[16];
#pragma unroll
                    for (int ti = 0; ti < 16; ++ti) { const int t = tb * 16 + ti; const int tn = (t + 1 < TC) ? t + 1 : t; const int lo = tn * 64 + sq;
                        const f32x4 rr_n = *(const LAS f32x4*)(Lc + lo), ww_n = *(const LAS f32x4*)(Lc + 2048 + lo), kx_n = *(const LAS f32x4*)(Lc + 4096 + lo), an_n = *(const LAS f32x4*)(Lc + 6144 + lo), bb_n = *(const LAS f32x4*)(Lc + 8192 + lo);
                        const float v0_n = Lv[tn * 32 + sp], v1_n = Lv[tn * 32 + sp + 16];
                        const f32x2 an0 = {an[0], an[1]}, an1 = {an[2], an[3]}, w0 = {ww[0], ww[1]}, w1 = {ww[2], ww[3]}, k0 = {kx[0], kx[1]}, k1 = {kx[2], kx[3]}, b0 = {bb[0], bb[1]}, b1 = {bb[2], bb[3]}, r0 = {rr[0], rr[1]}, r1 = {rr[2], rr[3]};
                        const f32x2 p0 = S0a * an0 + S0b * an1, p1 = S1a * an0 + S1b * an1;
                        const float sa0 = red16(p0.x + p0.y), sa1 = red16(p1.x + p1.y);
                        const f32x2 sa0v = {sa0, sa0}, sa1v = {sa1, sa1}, v0v = {v0, v0}, v1v = {v1, v1};
                        S0a = S0a * w0 + (v0v * k0 + sa0v * b0); S0b = S0b * w1 + (v0v * k1 + sa0v * b1);
                        S1a = S1a * w0 + (v1v * k0 + sa1v * b0); S1b = S1b * w1 + (v1v * k1 + sa1v * b1);
                        const f32x2 q0 = S0a * r0 + S0b * r1, q1 = S1a * r0 + S1b * r1;
                        py0[ti] = q0.x + q0.y; py1[ti] = q1.x + q1.y;
                        rr = rr_n; ww = ww_n; kx = kx_n; an = an_n; bb = bb_n; v0 = v0_n; v1 = v1_n; }
                    const bool b8 = (tid & 8) != 0, b4 = (tid & 4) != 0, b2 = (tid & 2) != 0, b1 = (tid & 1) != 0;
                    const float yk0 = tred16(py0, b8, b4, b2, b1), yk1 = tred16(py1, b8, b4, b2, b1);
                    Ly[(tb * 16 + (tid & 15)) * 32 + sp] = yk0; Ly[(tb * 16 + (tid & 15)) * 32 + sp + 16] = yk1; }
            }
        } else {

            unsigned long long xgv = 0ull; if (c >= 2) xgv = __hip_atomic_load(xg_peer + (size_t)(c - 2) * 64 + lane, __ATOMIC_RELAXED, __HIP_MEMORY_SCOPE_AGENT);
            if (c + 1 < NCH) SP_FETCH(c + 1);
            float st1 = 0.f, st2 = 0.f;
            if (c >= 1 && c <= NCH) { const f32x4 y = *(const LAS f32x4*)(YB + ((c - 1) % 3) * 1024 + pt * 32 + r4);
                st1 = (y[0] + y[1]) + (y[2] + y[3]); st2 = (y[0] * y[0] + y[1] * y[1]) + (y[2] * y[2] + y[3] * y[3]); st1 = red8(st1); st2 = red8(st2);
                if ((ht & 7) == 0) { ST[((c - 1) & 3) * 64 + pt] = st1; ST[((c - 1) & 3) * 64 + 32 + pt] = st2; } }
            if (c >= 2) { const int cf = c - 2; gu64_t* g = xg_peer + (size_t)cf * 64; unsigned long long x = xgv; unsigned spins = 0;
                while (!__all((unsigned)(x >> 32) == (unsigned)(tagbase + cf + 1))) { if (++spins > (1u << 22)) break; __builtin_amdgcn_s_sleep(1); x = __hip_atomic_load(g + lane, __ATOMIC_RELAXED, __HIP_MEMORY_SCOPE_AGENT); }
                const float pv = __uint_as_float((unsigned)x); const int tl = (lane >> 3) + 8 * (wv - 4);
                const float s1p = __int_as_float(__builtin_amdgcn_ds_bpermute(tl << 2, __float_as_int(pv))), s2p = __int_as_float(__builtin_amdgcn_ds_bpermute((32 + tl) << 2, __float_as_int(pv)));
                const float s1 = ST[(cf & 3) * 64 + pt] + s1p, s2 = ST[(cf & 3) * 64 + 32 + pt] + s2p; const float mu = s1 * (1.0f / 64.0f); const float var = fmaxf(s2 * (1.0f / 64.0f) - mu * mu, 0.f);
                const float rs = __builtin_amdgcn_rsqf(var + GN_EPS); const float bon = FB[(cf & 3) * 32 + pt];
                const f32x4 y = *(const LAS f32x4*)(YB + (cf % 3) * 1024 + pt * 32 + r4), v = *(const LAS f32x4*)(VB + (cf & 3) * 1024 + pt * 32 + r4), gg = *(const LAS f32x4*)(FG + (cf & 3) * 1024 + pt * 32 + r4);
                const f32x4 gn_g = *(const f32x4*)(a.in[I_CGNG] + (size_t)j * D + cbase + own + r4), gn_b = *(const f32x4*)(a.in[I_CGNB] + (size_t)j * D + cbase + own + r4);
                const f32x4 o = ((y - mu) * rs * gn_g + gn_b + bon * v) * gg;
                u32x2 w2; w2.x = cvt_pk_bf16(o[0], o[1]); w2.y = cvt_pk_bf16(o[2], o[3]); *(u32x2*)(Y + (size_t)(b * SEQ + cf * TC + pt) * D + cbase + own + r4) = w2; }
            if (cv_on) { if (cvd.nc == 2) tr_finish<2>(cvd.WT, cvd.ldk, cvd.k0, cvd.drow, cvd.gain, cvx, lane); else tr_finish<1>(cvd.WT, cvd.ldk, cvd.k0, cvd.drow, cvd.gain, cvx1, lane); }
            if (c + 1 < NCH) SP_PREP(c + 1);
            if (c >= 1 && c <= NCH && (ht & 7) == 0) { gu64_t* g = xg_mine + (size_t)(c - 1) * 64;
                __hip_atomic_store(g + pt, ((unsigned long long)(unsigned)(tagbase + c) << 32) | __float_as_uint(st1), __ATOMIC_RELAXED, __HIP_MEMORY_SCOPE_AGENT);
                __hip_atomic_store(g + 32 + pt, ((unsigned long long)(unsigned)(tagbase + c) << 32) | __float_as_uint(st2), __ATOMIC_RELAXED, __HIP_MEMORY_SCOPE_AGENT); }
            if (cv_on) { ++cv_it; cv_on = cv_it < cv_end; if (cv_on) { tr_next(cvd, cv_it); if (cvd.nc == 2) tr_load<2>(cvd.W, cvd.N, cvd.k0, cvd.n0, cvx, lane); else tr_load<1>(cvd.W, cvd.N, cvd.k0, cvd.n0, cvx1, lane); } }
        }
        __syncthreads();
    }
    if (is_s) __builtin_amdgcn_s_setprio(0);
    while (cv_on) {
        if (cvd.nc == 2) tr_finish<2>(cvd.WT, cvd.ldk, cvd.k0, cvd.drow, cvd.gain, cvx, lane); else tr_finish<1>(cvd.WT, cvd.ldk, cvd.k0, cvd.drow, cvd.gain, cvx1, lane);
        ++cv_it; cv_on = cv_it < cv_end; if (cv_on) { tr_next(cvd, cv_it); if (cvd.nc == 2) tr_load<2>(cvd.W, cvd.N, cvd.k0, cvd.n0, cvx, lane); else tr_load<1>(cvd.W, cvd.N, cvd.k0, cvd.n0, cvx1, lane); } }
#undef SP_FETCH
#undef SP_PREP
}
#undef a

__device__ __forceinline__ void final_norm(int G, int wv) {
    KArgs ap = kargs();
#define a (*ap)
    asm volatile("" : "+s"(wv)); int tid = TID_FROM_WAVE(wv);
    const int lane = tid & 63, wave = wv;
    const bf16_t* hi = (const bf16_t*)(a.ws + WS_HB1); const unsigned char* lo = a.ws + WS_H; const float* ss = (const float*)(a.ws + WS_SS) + (size_t)16 * M; const float* gn = a.in[I_FNORM];
    int bid = blockIdx.x; asm volatile("" : "+s"(bid), "+s"(G)); const int gw = bid * NWAVES + wave, NGW = G * NWAVES;
    for (int row = gw; row < M; row += NGW) { const float rs = rstd_of(ss[row]);
#pragma unroll
        for (int q = 0; q < 8; ++q) { const int c = (q * 64 + lane) * 4; *(f32x4*)(a.out + (size_t)row * D + c) = hl4(*(const u32x2*)(hi + (size_t)row * D + c), *(const unsigned*)(lo + (size_t)row * D + c)) * rs * *(const f32x4*)(gn + c); } }
}

#undef a
constexpr int PH_PER_LAYER = 10, N_PHASES = 2 + DEPTH * PH_PER_LAYER;
#define IN(k) (kargs()->ph_lo <= (k) && (k) < kargs()->ph_hi)
#define SEAM(k) do { if (IN(k) && IN((k) + 1)) { XcdBarrier bar_; bar_.bar = (unsigned*)(kargs()->ws + WS_CTL) + CW_BAR; bar_.x = xb_xcc_id(); bar_.st = (volatile LAS unsigned*)(lds + MISC_OFF) + 8; xcd_barrier(bar_, wv); } } while (0)
#define SITE KArgs ap = kargs(); unsigned char* ws = ap->ws; int G = gridDim.x, bid = blockIdx.x; asm volatile("" : "+s"(G), "+s"(bid)); float* SSb = (float*)(ws + WS_SS); unsigned char* HL = ws + WS_H; bf16_t* HB0 = (bf16_t*)(ws + WS_HB0); bf16_t* HB1 = (bf16_t*)(ws + WS_HB1); bf16_t* HF = (bf16_t*)(ws + WS_HF); \
             (void)SSb; (void)HL; (void)HB0; (void)HB1; (void)HF

#define IDLE_CONVERT(slot) do { if ((slot) >= 0) { int G_ = gridDim.x, bid_ = blockIdx.x; asm volatile("" : "+s"(G_), "+s"(bid_)); const int first_ = G_ > 128 ? 128 : 0; \
    if (bid_ >= first_) convert_items(CV_A + ((slot) > 0 ? cvq_end((slot) > 0 ? (slot) - 1 : 0) : 0), CV_A + cvq_end((slot) >= 0 ? (slot) : 0), (bid_ - first_) * NWAVES + wv, (G_ - first_) * NWAVES, lane_id()); } } while (0)
template <int L> __device__ __forceinline__ void layer_phases(LAS unsigned char* lds, int wv) {
        constexpr int SLOT_GU1 = L == 0 ? 0 : (L == 1 ? 2 : (L == 2 ? 5 : 7)), SLOT_GU2 = L == 0 ? 1 : (L == 1 ? 4 : (L == 2 ? 6 : 9)), SLOT_SCAN = L == 1 ? 3 : (L == 3 ? 8 : -1);
        constexpr int base = 1 + L * PH_PER_LAYER, j = L >> 1;
        if (IN(base + 0)) { SITE; pg8::GemmPlain<D, D, D> g{HB1, (const bf16_t*)(ws + WS_WGU) + (size_t)(2 * L) * 2 * FF * D}; pg8::StaticOrder S; S.init(M, 2 * FF, G, bid);
            pg8::EpiGU E{HF, SSb + (size_t)(4 * L + 0) * M}; pg8::gemm_phase(lds, g, S, E, wv); IDLE_CONVERT(SLOT_GU1); }
        SEAM(base + 0);
        if (IN(base + 1)) { SITE; pg8::GemmPlain<FF, FF, FF> g{HF, (const bf16_t*)(ws + WS_WD) + (size_t)(2 * L) * D * FF}; pg8::StaticOrder S; S.init(M, D, G, bid);
            pg8::EpiResid E{HB1, HB0, HL, SSb + (size_t)(4 * L + 1) * M, 0.5f}; pg8::gemm_phase(lds, g, S, E, wv); }
        SEAM(base + 1);
        if ((L & 1) == 0) {
            if (IN(base + 2)) { SITE; pg8::GemmPlain<D, D, D> g{HB0, (const bf16_t*)(ws + WS_WEIN) + (size_t)j * EIN * D}; pg8::StaticOrder S; S.init(M, EIN, G, bid);
                pg8::EpiEvenIn E{(bf16_t*)(ws + WS_EA), (float*)(ws + WS_LOGF), SSb + (size_t)(4 * L + 1) * M, (const float*)(ws + WS_LB) + (size_t)L * 1024};
                pg8::gemm_phase(lds, g, S, E, wv); }
            SEAM(base + 2);
            if (IN(base + 3)) { int G = gridDim.x, bid = blockIdx.x; asm volatile("" : "+s"(G), "+s"(bid)); { int gp = -1; for (int u = bid; u < 512; u += G) { gmlp_unit(lds, u, j, wv, (u & 7) == gp); gp = u & 7; } } hgrn_p1_all(lds, wv); }
            SEAM(base + 3);
            if (IN(base + 4)) hgrn_p2(gridDim.x, wv);
            SEAM(base + 4);
            if (IN(base + 5)) hgrn_p3_all(lds, j, wv);
            SEAM(base + 5);
            if (IN(base + 6)) { SITE; pg8::GemmPlain<D, D, D> g{(const bf16_t*)(ws + WS_AB), (const bf16_t*)(ws + WS_WEOUT) + (size_t)j * D * D}; pg8::StaticOrder S; S.init(M, D, G, bid);
                pg8::EpiResid E{HB0, HB0, HL, SSb + (size_t)(4 * L + 2) * M, 1.0f}; pg8::gemm_phase(lds, g, S, E, wv); }
            SEAM(base + 6);
        } else {
            if (IN(base + 2)) rwkv_mix(gridDim.x, L, j, wv);
            SEAM(base + 2);
            if (IN(base + 3)) { SITE; pg8::GemmRwkvIn g{(const bf16_t*)(ws + WS_XM), (const bf16_t*)(ws + WS_WRIN) + (size_t)j * RIN_N * D}; pg8::StaticOrder S; S.init(M, j == 1 ? RIN_N : RIN_N - 256, G, bid);
                pg8::EpiRwkvIn E{ws, j}; pg8::gemm_phase(lds, g, S, E, wv); }
            SEAM(base + 3);
            if (IN(base + 4)) { SITE; pg8::GemmLoraOut g{(const bf16_t*)(ws + WS_T), (const bf16_t*)(ws + WS_WL2) + (size_t)j * 8192 * 256}; pg8::StaticOrder S; S.init(M, j == 1 ? 8192 : 6144, G, bid);
                pg8::EpiLoraOut E{(bf16_t*)(ws + WS_WAGV), (const float*)(ws + WS_LBIAS) + (size_t)j * 4 * D};
                pg8::gemm_phase(lds, g, S, E, wv); }
            SEAM(base + 4);
            if (IN(base + 5)) { int G = gridDim.x, bid = blockIdx.x; asm volatile("" : "+s"(G), "+s"(bid)); if (G == 256) { rwkv_scan_split(lds, bid >> 1, bid & 1, j, wv, SLOT_SCAN >= 0 ? CV_A + cvq_end(SLOT_SCAN > 0 ? SLOT_SCAN - 1 : 0) : 0, SLOT_SCAN >= 0 ? CV_A + cvq_end(SLOT_SCAN >= 0 ? SLOT_SCAN : 0) : 0); } else { for (int u = bid; u < 128; u += G) rwkv_scan_unit(lds, u, j, wv); IDLE_CONVERT(SLOT_SCAN); } }
            SEAM(base + 5);
            if (IN(base + 6)) { SITE; pg8::GemmPlain<D, D, D> g{(const bf16_t*)(ws + WS_Y), (const bf16_t*)(ws + WS_WO) + (size_t)j * D * D}; pg8::StaticOrder S; S.init(M, D, G, bid);
                pg8::EpiResid E{HB0, HB0, HL, SSb + (size_t)(4 * L + 2) * M, 1.0f}; pg8::gemm_phase(lds, g, S, E, wv); }
            SEAM(base + 6);
        }
        if (IN(base + 7)) { SITE; pg8::GemmPlain<D, D, D> g{HB0, (const bf16_t*)(ws + WS_WGU) + (size_t)(2 * L + 1) * 2 * FF * D}; pg8::StaticOrder S; S.init(M, 2 * FF, G, bid);
            pg8::EpiGU E{HF, SSb + (size_t)(4 * L + 2) * M}; pg8::gemm_phase(lds, g, S, E, wv);
            if (G == 256 && bid >= 128) { pg8::GemmPlain<PLE, PLE, PLE> g2{(const bf16_t*)(ws + WS_PB) + (size_t)L * M * PLE, (const bf16_t*)(ws + WS_WPP) + (size_t)L * D * PLE}; pg8::StaticOrder S2; S2.init(M, D, 128, bid - 128);
              pg8::EpiStore E2{(bf16_t*)(ws + WS_PW), D}; pg8::gemm_phase(lds, g2, S2, E2, wv); }
            IDLE_CONVERT(SLOT_GU2); }
        SEAM(base + 7);
        if (IN(base + 8)) {
            { SITE; pg8::GemmPlain<FF, FF, FF> g{HF, (const bf16_t*)(ws + WS_WD) + (size_t)(2 * L + 1) * D * FF}; pg8::StaticOrder S; S.init(M, D, G, bid);
              pg8::EpiResid E{HB0, HB0, HL, SSb + (size_t)(4 * L + 3) * M, 0.5f}; pg8::gemm_phase(lds, g, S, E, wv); }
            if (gridDim.x != 256) { SITE; pg8::GemmPlain<PLE, PLE, PLE> g{(const bf16_t*)(ws + WS_PB) + (size_t)L * M * PLE, (const bf16_t*)(ws + WS_WPP) + (size_t)L * D * PLE}; pg8::StaticOrder S; S.init(M, D, G, bid);
              pg8::EpiStore E{(bf16_t*)(ws + WS_PW), D}; pg8::gemm_phase(lds, g, S, E, wv); }
        }
        SEAM(base + 8);
        if (IN(base + 9)) { SITE; pg8::GemmPlain<D, D, D> g{HB0, (const bf16_t*)(ws + WS_WPG) + (size_t)L * D * D}; pg8::StaticOrder S; S.init(M, D, G, bid);
            pg8::EpiPLE E{HB0, HB1, HL, SSb + (size_t)(4 * L + 4) * M, SSb + (size_t)(4 * L + 3) * M, (const bf16_t*)(ws + WS_PW)}; pg8::gemm_phase(lds, g, S, E, wv); }
        SEAM(base + 9);
}

__global__ void __launch_bounds__(NTHR, 2) mega(Args a_unused) {
    extern __shared__ __attribute__((aligned(16))) unsigned char lds_raw[];
    LAS unsigned char* lds = (LAS unsigned char*)lds_raw;
    const int wv = __builtin_amdgcn_readfirstlane((int)threadIdx.x >> 6);
    if (threadIdx.x < 32) ((volatile LAS unsigned*)(lds + MISC_OFF))[threadIdx.x] = 0u;
    __syncthreads();
    { KArgs ap = kargs(); if (ap->use_bar) (void)xcd_barrier_post((unsigned*)(ap->ws + WS_CTL) + CW_BAR, (volatile LAS unsigned*)(lds + MISC_OFF) + 8); }
    if (IN(0)) prologue(lds, gridDim.x, wv);
    SEAM(0);

    layer_phases<0>(lds, wv); layer_phases<1>(lds, wv); layer_phases<2>(lds, wv); layer_phases<3>(lds, wv);
    if (IN(N_PHASES - 1)) final_norm(gridDim.x, wv);
#undef IN
#undef SEAM
#undef SITE
#undef IDLE_CONVERT
}

extern "C" void kernel_launch(void* const* d_in, const int* in_sizes, int n_in, void* d_out, int out_size, void* d_ws, size_t ws_size, hipStream_t stream) {
    static int grid = 0;
    if (grid == 0) {
        if (n_in != 37 || out_size != M * D || ws_size < WS_END) { fprintf(stderr, "kernel_launch: unexpected problem (n_in %d, out %d, ws %zu < %zu)\n", n_in, out_size, ws_size, (size_t)WS_END); grid = -1; return; }
        int dev = 0, cus = 0, per_cu = 0;
        if (hipGetDevice(&dev) != hipSuccess || hipDeviceGetAttribute(&cus, hipDeviceAttributeMultiprocessorCount, dev) != hipSuccess) { grid = -1; return; }
        if (hipFuncSetAttribute((const void*)mega, hipFuncAttributeMaxDynamicSharedMemorySize, LDS_BYTES) != hipSuccess) { fprintf(stderr, "kernel_launch: hipFuncSetAttribute failed\n"); grid = -1; return; }
        if (hipOccupancyMaxActiveBlocksPerMultiprocessor(&per_cu, (const void*)mega, NTHR, LDS_BYTES) != hipSuccess || per_cu < 1) fprintf(stderr, "kernel_launch: occupancy query says %d\n", per_cu);
        (void)hipGetLastError();
        grid = cus;
    }
    if (grid < 0) return;
    (void)hipMemsetAsync((char*)d_ws + WS_CTL, 0, CTL_ZERO_BYTES, stream);
    Args a{};
    for (int i = 0; i < 37; ++i) a.in[i] = (const float*)d_in[i];
    a.out = (float*)d_out; a.ws = (unsigned char*)d_ws; a.pad = 0;
#if N_LAUNCH_MODE == 0
    a.ph_lo = 0; a.ph_hi = N_PHASES; a.use_bar = 1;
    hipLaunchKernelGGL(mega, dim3(grid), dim3(NTHR), LDS_BYTES, stream, a);
#else
    a.use_bar = 0;
    for (int p = 0; p < N_PHASES; ++p) { a.ph_lo = p; a.ph_hi = p + 1; hipLaunchKernelGGL(mega, dim3(grid), dim3(NTHR), LDS_BYTES, stream, a); }
#endif
}
```

```cpp
#include <hip/hip_runtime.h>
#include <cstdio>
#include <cstdint>

#ifndef N_LAUNCH_MODE
#define N_LAUNCH_MODE 0
#endif

#define LAS __attribute__((address_space(3)))
#define GAS __attribute__((address_space(1)))
typedef unsigned short bf16_t;
typedef short bf16x8 __attribute__((ext_vector_type(8)));
typedef float f32x4 __attribute__((ext_vector_type(4)));
typedef float f32x2 __attribute__((ext_vector_type(2)));
typedef unsigned u32x4 __attribute__((ext_vector_type(4)));
typedef unsigned u32x2 __attribute__((ext_vector_type(2)));

constexpr int D = 2048, SEQ = 2048, NB = 4, DEPTH = 4, M = NB * SEQ, PLE = 256, FF = 5632;
constexpr int EIN = 6144, RIN_N = 7168, NTHR = 512, NWAVES = 8;
constexpr float RMS_EPS = 1e-6f, GN_EPS = 64e-5f;

constexpr size_t MiB = 1u << 20;
constexpr size_t WS_CTL = 0, CTL_ZERO_BYTES = 65536, WS_SS = 1 * MiB;
constexpr size_t WS_WGU = 2 * MiB, WS_WD = 354 * MiB, WS_WPG = 530 * MiB, WS_WPP = 562 * MiB, WS_WEIN = 566 * MiB, WS_WEOUT = 614 * MiB;
constexpr size_t WS_WRIN = 630 * MiB, WS_WL2 = 686 * MiB, WS_WO = 694 * MiB;
constexpr size_t WS_H = 710 * MiB, WS_HB0 = 774 * MiB, WS_HB1 = 806 * MiB, WS_PB = 838 * MiB, WS_PW = 854 * MiB, WS_VF = 886 * MiB, WS_LB = 918 * MiB;
constexpr size_t WS_LBIAS = WS_LB + 65536;
constexpr size_t WS_UNION = 919 * MiB;
constexpr size_t WS_HF = WS_UNION;
constexpr size_t WS_EA = WS_UNION, WS_LOGF = WS_UNION + 96 * MiB, WS_OI = WS_UNION + 128 * MiB, WS_U = WS_UNION + 160 * MiB, WS_DC = WS_UNION + 224 * MiB, WS_AB = WS_UNION + 225 * MiB;
constexpr size_t WS_XM = WS_UNION, WS_RKV = WS_UNION + 192 * MiB, WS_T = WS_UNION + 288 * MiB, WS_WAGV = WS_UNION + 304 * MiB, WS_Y = WS_UNION + 432 * MiB;
constexpr size_t WS_XG = WS_UNION + 464 * MiB, XG_BYTES = 8 * MiB;
constexpr size_t WS_END = WS_XG + XG_BYTES;
static_assert(WS_WGU + 8ull * 2 * FF * D * 2 <= WS_WD && WS_WD + 8ull * D * FF * 2 <= WS_WPG && WS_WRIN + 2ull * RIN_N * D * 2 <= WS_WL2 && WS_WL2 + 2ull * 8192 * 256 * 2 <= WS_WO, "ws map");
static_assert(WS_HF + (size_t)M * FF * 2 <= WS_END && WS_AB + (size_t)M * D * 2 <= WS_END && WS_Y + (size_t)M * D * 2 <= WS_END, "ws map");
constexpr int CW_TMO = 0, CW_BAR = 4096;

__device__ __forceinline__ float bf2f(unsigned b) { return __uint_as_float(b << 16); }
__device__ __forceinline__ float lo8_dec(float r, unsigned w, int i) { const int eb = (int)(__float_as_uint(r) & 0x7F800000u) - (15 << 23); return (float)(((int)(w << (24 - 8 * i))) >> 24) * __uint_as_float((unsigned)(eb > 0 ? eb : 0)); }
__device__ __forceinline__ unsigned lo8_enc(float n, float r) { const unsigned mb = 0x86800000u - (__float_as_uint(r) & 0x7F800000u); return (unsigned)(int)rintf(fminf(fmaxf((n - r) * __uint_as_float(mb), -128.0f), 127.0f)) & 0xffu; }
__device__ __forceinline__ unsigned lo8_pack(unsigned t0, unsigned t1, unsigned t2, unsigned t3) { return (t0 & 0xffu) | ((t1 & 0xffu) << 8) | ((t2 & 0xffu) << 16) | (t3 << 24); }
typedef __bf16 bf16x2_t __attribute__((ext_vector_type(2)));
__device__ __forceinline__ unsigned cvt_pk_bf16(float lo, float hi) { const f32x2 v = {lo, hi}; const bf16x2_t b = __builtin_convertvector(v, bf16x2_t); return __builtin_bit_cast(unsigned, b); }
__device__ __forceinline__ float sigm(float x) { return __builtin_amdgcn_rcpf(1.0f + __builtin_amdgcn_exp2f(-1.44269504f * x)); }
__device__ __forceinline__ float siluf(float x) { return x * sigm(x); }
__device__ __forceinline__ float tanhf_(float x) { return 2.0f * sigm(2.0f * x) - 1.0f; }
__device__ __forceinline__ float gelu_t(float x) { return x * sigm(1.5957691216f * (x + 0.044715f * x * x * x)); }
__device__ __forceinline__ float expf_(float x) { return __builtin_amdgcn_exp2f(1.44269504f * x); }
__device__ __forceinline__ float logf_(float x) { return 0.69314718056f * __builtin_amdgcn_logf(x); }
__device__ __forceinline__ float rstd_of(float ss) { return __builtin_amdgcn_rsqf(ss * (1.0f / D) + RMS_EPS); }
template <int CTRL> __device__ __forceinline__ float dppf(float v) { return __int_as_float(__builtin_amdgcn_update_dpp(0, __float_as_int(v), CTRL, 0xF, 0xF, true)); }
__device__ __forceinline__ float red4(float v) { v += dppf<0xB1>(v); v += dppf<0x4E>(v); return v; }
__device__ __forceinline__ float red8(float v) { v = red4(v); v += dppf<0x141>(v); return v; }
__device__ __forceinline__ float red16(float v) { v = red8(v); v += dppf<0x140>(v); return v; }
__device__ __forceinline__ float tred16(float (&v)[16], bool b8, bool b4, bool b2, bool b1) {
#pragma unroll
    for (int j = 0; j < 8; ++j) { const float send = b8 ? v[j] : v[j + 8], keep = b8 ? v[j + 8] : v[j]; v[j] = keep + dppf<0x140>(send); }
#pragma unroll
    for (int j = 0; j < 4; ++j) { const float send = b4 ? v[j] : v[j + 4], keep = b4 ? v[j + 4] : v[j]; v[j] = keep + dppf<0x141>(send); }
#pragma unroll
    for (int j = 0; j < 2; ++j) { const float send = b2 ? v[j] : v[j + 2], keep = b2 ? v[j + 2] : v[j]; v[j] = keep + dppf<0x4E>(send); }
    { const float send = b1 ? v[0] : v[1], keep = b1 ? v[1] : v[0]; v[0] = keep + dppf<0xB1>(send); }
    return v[0];
}
__device__ __forceinline__ int lane_id() { int l; asm volatile("v_mbcnt_lo_u32_b32 %0, -1, 0\n\tv_mbcnt_hi_u32_b32 %0, -1, %0" : "=v"(l)); return l; }
__device__ __forceinline__ float shfl_xor_f(float v, int mask) { return __int_as_float(__builtin_amdgcn_ds_bpermute((lane_id() ^ mask) << 2, __float_as_int(v))); }
__device__ __forceinline__ float wave_sum(float v) { v = red16(v); v += shfl_xor_f(v, 16); v += shfl_xor_f(v, 32); return v; }

#define TID_FROM_WAVE(wv) ((wv) * 64 + lane_id())

namespace pg8 {
constexpr int BM = 256, BK = 64, HALF = 128, HTB = HALF * BK * 2, STAGE_BYTES = 8 * HTB, NXCD = 8, WGM = 8;
__host__ __device__ __forceinline__ int lds_byte(int r, int c) { const int st = (r >> 4) * 2 + (c >> 5), rr = r & 15, cc = c & 31, ob = rr * 64 + cc * 2; return st * 1024 + (ob ^ (((ob >> 9) & 1) << 5)); }
__host__ __device__ __forceinline__ void stage_rc(int b, int& R, int& C) { const int st = b / 1024, sb = b % 1024, swz = sb ^ (((sb >> 9) & 1) << 5); R = (st >> 1) * 16 + swz / 64; C = (st & 1) * 32 + (swz % 64) / 2; }
__host__ __device__ __forceinline__ int perm32(int rho) { const int n = rho >> 4, i = rho & 15; return 8 * (i >> 2) + 4 * n + (i & 3); }
struct Unit { int pm, pn; };
struct StaticOrder {
    int nM, nN, nwg, G, c;
    __host__ __device__ void init(int M_, int N_, int G_, int c_) { nM = M_ / BM; nN = N_ / BM; nwg = nM * nN; G = G_; c = c_; }
    __host__ __device__ bool next(int i, Unit& u) const {
        const long L = (long)i * G + c; if (L >= nwg) return false;
        int wgid = (int)L; { const int q = nwg / NXCD, r = nwg % NXCD, xcd = wgid % NXCD, off = wgid / NXCD; wgid = (xcd < r ? xcd * (q + 1) : r * (q + 1) + (xcd - r) * q) + off; }
        const int nig = WGM * nN, gid = wgid / nig, fm = gid * WGM, gsz = (nM - fm) < WGM ? (nM - fm) : WGM;
        u.pm = fm + ((wgid % nig) % gsz); u.pn = (wgid % nig) / gsz; return true;
    }
};
template <int LDA, int LDB, int KK> struct GemmPlain { const bf16_t* A; const bf16_t* Bt; static constexpr int lda = LDA, ldb = LDB, K = KK;
    __device__ __forceinline__ const void* a_base() const { return A; } __device__ __forceinline__ const void* b_base() const { return Bt; }
    __device__ __forceinline__ unsigned a_off(const Unit& u) const { return (unsigned)u.pm * (BM * lda * 2); }
    __device__ __forceinline__ unsigned b_off(const Unit& u) const { return (unsigned)u.pn * (BM * ldb * 2); } };
struct GemmRwkvIn { const bf16_t* XM; const bf16_t* Bt; static constexpr int lda = D, ldb = D, K = D;
    __device__ __forceinline__ const void* a_base() const { return XM; } __device__ __forceinline__ const void* b_base() const { return Bt; }
    __device__ __forceinline__ unsigned a_off(const Unit& u) const { const int s = u.pn < 24 ? (u.pn >> 3) : (u.pn == 27 ? 2 : u.pn - 21); return (unsigned)s * (unsigned)(M * D * 2) + (unsigned)u.pm * (BM * lda * 2); }
    __device__ __forceinline__ unsigned b_off(const Unit& u) const { return (unsigned)u.pn * (BM * ldb * 2); } };
struct GemmLoraOut { const bf16_t* T; const bf16_t* Bt; static constexpr int lda = 1024, ldb = 256, K = 256;
    __device__ __forceinline__ const void* a_base() const { return T; } __device__ __forceinline__ const void* b_base() const { return Bt; }
    __device__ __forceinline__ unsigned a_off(const Unit& u) const { return (unsigned)u.pm * (BM * lda * 2) + (unsigned)(u.pn >> 3) * 512u; }
    __device__ __forceinline__ unsigned b_off(const Unit& u) const { return (unsigned)u.pn * (BM * ldb * 2); } };

#define EPI_ROW(ai, m) (u.pm * BM + (ai) * HALF + wr * 64 + (m) * 16 + fr)
#define EPI_COL(bj)    (u.pn * BM + (bj) * HALF + wc * 32 + 8 * fq)
#define EPI_ARGS const f32x4 (&acc)[2][2][4][2], const Unit& u, int wr, int wc, int fr, int fq
#define EPI_FENCE asm volatile("" ::: "memory")

__device__ __forceinline__ u32x4 pack8(const f32x4 a, const f32x4 b) { u32x4 w; w.x = cvt_pk_bf16(a[0], a[1]); w.y = cvt_pk_bf16(a[2], a[3]); w.z = cvt_pk_bf16(b[0], b[1]); w.w = cvt_pk_bf16(b[2], b[3]); return w; }
__device__ __forceinline__ void unpack8(const u32x4 w, f32x4& a, f32x4& b) { a[0] = bf2f(w.x & 0xffffu); a[1] = bf2f(w.x >> 16); a[2] = bf2f(w.y & 0xffffu); a[3] = bf2f(w.y >> 16); b[0] = bf2f(w.z & 0xffffu); b[1] = bf2f(w.z >> 16); b[2] = bf2f(w.w & 0xffffu); b[3] = bf2f(w.w >> 16); }

struct EpiGU { static constexpr bool PERM = true;
    bf16_t* H; const float* ss;
    __device__ __forceinline__ void operator()(EPI_ARGS) const {
        const int colo = u.pn * 128 + wc * 32 + 8 * fq;
#pragma unroll
        for (int ai = 0; ai < 2; ++ai)
#pragma unroll
            for (int m = 0; m < 4; ++m) { const int row = EPI_ROW(ai, m); const float rs = rstd_of(ss[row]); const float c1 = -1.44269504f * rs, c2 = rs * rs; f32x4 o0, o1;
#pragma unroll
                for (int j = 0; j < 4; ++j) { const float g0 = acc[ai][0][m][0][j], g1 = acc[ai][0][m][1][j];
                    o0[j] = (g0 * acc[ai][1][m][0][j]) * c2 * __builtin_amdgcn_rcpf(1.0f + __builtin_amdgcn_exp2f(g0 * c1));
                    o1[j] = (g1 * acc[ai][1][m][1][j]) * c2 * __builtin_amdgcn_rcpf(1.0f + __builtin_amdgcn_exp2f(g1 * c1)); }
                *(u32x4*)(H + (size_t)row * FF + colo) = pack8(o0, o1); }
    }
};
struct EpiResid { static constexpr bool PERM = true;
    const bf16_t* hin; bf16_t* hout; unsigned char* lo; float* ssn; float scale;
    __device__ __forceinline__ void operator()(EPI_ARGS) const {
#pragma unroll
        for (int ai = 0; ai < 2; ++ai)
#pragma unroll
            for (int m = 0; m < 4; ++m) { const int row = EPI_ROW(ai, m); float sq = 0.f;
#pragma unroll
                for (int bj = 0; bj < 2; ++bj) { const int col = EPI_COL(bj); const size_t o = (size_t)row * D + col;
                    f32x4 a0, a1, b0, b1; unpack8(*(const u32x4*)(hin + o), a0, a1); const u32x2 lw = *(const u32x2*)(lo + o);
#pragma unroll
                    for (int i = 0; i < 4; ++i) { b0[i] = lo8_dec(a0[i], lw.x, i); b1[i] = lo8_dec(a1[i], lw.y, i); }
                    const f32x4 n0 = (a0 + b0) + acc[ai][bj][m][0] * scale, n1 = (a1 + b1) + acc[ai][bj][m][1] * scale;
                    const u32x4 hi = pack8(n0, n1); f32x4 r0, r1; unpack8(hi, r0, r1);
                    u32x2 lq; lq.x = lo8_pack(lo8_enc(n0[0], r0[0]), lo8_enc(n0[1], r0[1]), lo8_enc(n0[2], r0[2]), lo8_enc(n0[3], r0[3])); lq.y = lo8_pack(lo8_enc(n1[0], r1[0]), lo8_enc(n1[1], r1[1]), lo8_enc(n1[2], r1[2]), lo8_enc(n1[3], r1[3]));
                    *(u32x4*)(hout + o) = hi; *(u32x2*)(lo + o) = lq;
                    sq += (n0[0] * n0[0] + n0[1] * n0[1]) + (n0[2] * n0[2] + n0[3] * n0[3]) + (n1[0] * n1[0] + n1[1] * n1[1]) + (n1[2] * n1[2] + n1[3] * n1[3]); }
                sq += shfl_xor_f(sq, 16); sq += shfl_xor_f(sq, 32);
                if (fq == 0) atomicAdd(ssn + row, sq);
                if (m == 3) EPI_FENCE; }
    }
};
struct EpiPLE { static constexpr bool PERM = true;
    const bf16_t* hin; bf16_t* hout; unsigned char* lo; float* ssn; const float* ss; const bf16_t* pw;
    __device__ __forceinline__ void operator()(EPI_ARGS) const {
#pragma unroll
        for (int ai = 0; ai < 2; ++ai)
#pragma unroll
            for (int m = 0; m < 4; ++m) { const int row = EPI_ROW(ai, m); const float rs = rstd_of(ss[row]); float sq = 0.f;
#pragma unroll
                for (int bj = 0; bj < 2; ++bj) { const int col = EPI_COL(bj); const size_t o = (size_t)row * D + col;
                    f32x4 p0, p1; unpack8(*(const u32x4*)(pw + o), p0, p1);
                    f32x4 n0, n1; unpack8(*(const u32x4*)(hin + o), n0, n1); { const u32x2 lw = *(const u32x2*)(lo + o);
#pragma unroll
                      for (int i = 0; i < 4; ++i) { n0[i] += lo8_dec(n0[i], lw.x, i); n1[i] += lo8_dec(n1[i], lw.y, i); } }
#pragma unroll
                    for (int j = 0; j < 4; ++j) { n0[j] += sigm(acc[ai][bj][m][0][j] * rs) * p0[j]; n1[j] += sigm(acc[ai][bj][m][1][j] * rs) * p1[j]; }
                    { const u32x4 hi = pack8(n0, n1); f32x4 r0, r1; unpack8(hi, r0, r1); *(u32x4*)(hout + o) = hi;
                      u32x2 lq; lq.x = lo8_pack(lo8_enc(n0[0], r0[0]), lo8_enc(n0[1], r0[1]), lo8_enc(n0[2], r0[2]), lo8_enc(n0[3], r0[3])); lq.y = lo8_pack(lo8_enc(n1[0], r1[0]), lo8_enc(n1[1], r1[1]), lo8_enc(n1[2], r1[2]), lo8_enc(n1[3], r1[3]));
                      *(u32x2*)(lo + o) = lq; }
                    sq += (n0[0] * n0[0] + n0[1] * n0[1]) + (n0[2] * n0[2] + n0[3] * n0[3]) + (n1[0] * n1[0] + n1[1] * n1[1]) + (n1[2] * n1[2] + n1[3] * n1[3]); }
                sq += shfl_xor_f(sq, 16); sq += shfl_xor_f(sq, 32);
                if (fq == 0) atomicAdd(ssn + row, sq);
                if (m == 3) EPI_FENCE; }
    }
};
struct EpiStore { static constexpr bool PERM = true;
    bf16_t* O; int ldo;
    __device__ __forceinline__ void operator()(EPI_ARGS) const {
#pragma unroll
        for (int ai = 0; ai < 2; ++ai)
#pragma unroll
            for (int m = 0; m < 4; ++m) { const int row = EPI_ROW(ai, m);
#pragma unroll
                for (int bj = 0; bj < 2; ++bj) *(u32x4*)(O + (size_t)row * ldo + EPI_COL(bj)) = pack8(acc[ai][bj][m][0], acc[ai][bj][m][1]); }
    }
};
struct EpiEvenIn { static constexpr bool PERM = true;
    bf16_t* EA; float* LOGF; const float* ss; const float* lb;
    __device__ __forceinline__ void operator()(EPI_ARGS) const {
        const int grp = u.pn >> 2;
#pragma unroll
        for (int ai = 0; ai < 2; ++ai)
#pragma unroll
            for (int m = 0; m < 4; ++m) { const int row = EPI_ROW(ai, m); const float rs = rstd_of(ss[row]);
#pragma unroll
                for (int bj = 0; bj < 2; ++bj) { const int col = EPI_COL(bj); f32x4 v0 = acc[ai][bj][m][0] * rs, v1 = acc[ai][bj][m][1] * rs;
                    if (grp == 3) { const int c = col - 3072; const f32x4 l0 = *(const f32x4*)(lb + c), l1 = *(const f32x4*)(lb + c + 4);
#pragma unroll
                        for (int j = 0; j < 4; ++j) { v0[j] = logf_(fmaxf(l0[j] + (1.0f - l0[j]) * sigm(v0[j]), 1e-30f)); v1[j] = logf_(fmaxf(l1[j] + (1.0f - l1[j]) * sigm(v1[j]), 1e-30f)); }
                        float* lp = LOGF + (size_t)row * 1024 + c; *(f32x4*)lp = v0; *(f32x4*)(lp + 4) = v1;
                    } else {
                        if (grp <= 1) {
#pragma unroll
                            for (int j = 0; j < 4; ++j) { v0[j] = gelu_t(v0[j]); v1[j] = gelu_t(v1[j]); }
                        } else if (grp != 4) {
#pragma unroll
                            for (int j = 0; j < 4; ++j) { v0[j] = siluf(v0[j]); v1[j] = siluf(v1[j]); }
                        }
                        *(u32x4*)(EA + (size_t)row * EIN + col) = pack8(v0, v1);
                    } } }
    }
};
struct EpiRwkvIn { static constexpr bool PERM = true;
    unsigned char* ws; int jodd;
    __device__ __forceinline__ void operator()(EPI_ARGS) const {
        const int pn = u.pn;
        size_t off = WS_RKV + (size_t)(pn >> 3) * M * D * 2; int ld = D, cb = (pn & 7) * BM;
        if (pn >= 16 && jodd == 0) off = WS_VF;
        if (pn >= 24) { off = WS_T; ld = 1024; cb = (pn - 24) * BM; }
        bf16_t* dst = (bf16_t*)(ws + off);
#pragma unroll
        for (int ai = 0; ai < 2; ++ai)
#pragma unroll
            for (int m = 0; m < 4; ++m) { const int row = EPI_ROW(ai, m);
#pragma unroll
                for (int bj = 0; bj < 2; ++bj) { const int col = cb + bj * HALF + wc * 32 + 8 * fq; f32x4 v0 = acc[ai][bj][m][0], v1 = acc[ai][bj][m][1];
                    if (pn == 24) {
#pragma unroll
                        for (int j = 0; j < 4; ++j) { v0[j] = tanhf_(v0[j]); v1[j] = tanhf_(v1[j]); }
                    } else if (pn == 26) {
#pragma unroll
                        for (int j = 0; j < 4; ++j) { v0[j] = sigm(v0[j]); v1[j] = sigm(v1[j]); }
                    }
                    *(u32x4*)(dst + (size_t)row * ld + col) = pack8(v0, v1); } }
    }
};
struct EpiLoraOut { static constexpr bool PERM = true;
    bf16_t* O; const float* bias4;
    __device__ __forceinline__ void operator()(EPI_ARGS) const {
        const int grp = u.pn >> 3;
        bf16_t* dst = O + (size_t)grp * M * D;
#pragma unroll
        for (int bj = 0; bj < 2; ++bj) { const int col = (u.pn & 7) * BM + bj * HALF + wc * 32 + 8 * fq;
            const f32x4 b0 = *(const f32x4*)(bias4 + grp * D + col), b1 = *(const f32x4*)(bias4 + grp * D + col + 4);
#pragma unroll
            for (int ai = 0; ai < 2; ++ai)
#pragma unroll
                for (int m = 0; m < 4; ++m) { const int row = EPI_ROW(ai, m); f32x4 v0_ = acc[ai][bj][m][0] + b0, v1_ = acc[ai][bj][m][1] + b1;
                    if (grp != 2) { const float sc = grp == 0 ? 0.60653065971f : 1.0f;
#pragma unroll
                        for (int j = 0; j < 4; ++j) { v0_[j] = sc * sigm(v0_[j]); v1_[j] = sc * sigm(v1_[j]); } }
                    *(u32x4*)(dst + (size_t)row * D + col) = pack8(v0_, v1_); } }
    }
};

template <class Epi, class G, bool ALIGN_EPI = true, bool SP2 = true>
__device__ __forceinline__ void gemm_phase(LAS unsigned char* lds, const G g, const StaticOrder& S, const Epi& E, int wv) {
    asm volatile("" : "+s"(wv));
    const int lane = lane_id();
    const int wid = wv, tid = wv * 64 + lane, wr = wid >> 2, wc = wid & 3, fr = lane & 15, fq = lane >> 4;
    constexpr int K = G::K, nt = K / BK, lda = G::lda, ldb = G::ldb;
    unsigned voffA[2], voffB[2];
#pragma unroll
    for (int i = 0; i < 2; ++i) { int R, C; stage_rc(tid * 16 + i * 8192, R, C); const int Rb = Epi::PERM ? ((R & ~31) + perm32(R & 31)) : R;
        voffA[i] = (unsigned)(R * lda + C) * 2u; voffB[i] = (unsigned)(Rb * ldb + C) * 2u; }
    constexpr unsigned kstep = BK * 2u, hstepA = (unsigned)(HALF * lda * 2), hstepB = (unsigned)(HALF * ldb * 2);
    const __amdgpu_buffer_rsrc_t rsA = __builtin_amdgcn_make_buffer_rsrc((void*)g.a_base(), (short)0, 0x7FFFFFF0, 0x00020000), rsB = __builtin_amdgcn_make_buffer_rsrc((void*)g.b_base(), (short)0, 0x7FFFFFF0, 0x00020000);
    const unsigned ldsw = (unsigned)wid * 1024u;
    const int aoff = lds_byte(wr * 64 + fr, fq * 8), boff = lds_byte(wc * 32 + fr, fq * 8);
#define PG8_SA(b, h) (((b) * 2 + (h)) * HTB)
#define PG8_SB(b, h) ((4 + (b) * 2 + (h)) * HTB)
#define PG8_STAGE(bufoff, rs, soff, voff) do { _Pragma("unroll") for (int _i = 0; _i < 2; ++_i) \
        __builtin_amdgcn_raw_ptr_buffer_load_lds((rs), (LAS void*)(lds + (bufoff) + ldsw + _i * 8192), 16, (int)(voff)[_i], (int)(soff), 0, 0); } while (0)
#define PG8_LDA(dst, b, h) do { _Pragma("unroll") for (int m = 0; m < 4; ++m) _Pragma("unroll") for (int k = 0; k < 2; ++k) dst[m][k] = *(const LAS bf16x8*)(lds + PG8_SA(b, h) + aoff + m * 2048 + k * 1024); } while (0)
#define PG8_LDB(dst, b, h) do { _Pragma("unroll") for (int n = 0; n < 2; ++n) _Pragma("unroll") for (int k = 0; k < 2; ++k) dst[n][k] = *(const LAS bf16x8*)(lds + PG8_SB(b, h) + boff + n * 2048 + k * 1024); } while (0)
#define PG8_MMA(ai, bj, At, Bt) do { __builtin_amdgcn_s_setprio(1); _Pragma("unroll") for (int m = 0; m < 4; ++m) _Pragma("unroll") for (int n = 0; n < 2; ++n) _Pragma("unroll") for (int k = 0; k < 2; ++k) \
        acc[ai][bj][m][n] = __builtin_amdgcn_mfma_f32_16x16x32_bf16(Bt[n][k], At[m][k], acc[ai][bj][m][n], 0, 0, 0); __builtin_amdgcn_s_setprio(0); } while (0)
#define PG8_WAIT_V(n) asm volatile("s_waitcnt vmcnt(" #n ")" ::: "memory")
#define PG8_WAIT_L(n) asm volatile("s_waitcnt lgkmcnt(" #n ")" ::: "memory")
#define PG8_BAR __builtin_amdgcn_s_barrier()
#define PG8_SCHED __builtin_amdgcn_sched_barrier(0)
    Unit cur, nxt; int ui = 0;
    if (!S.next(0, cur)) return;
    f32x4 acc[2][2][4][2];
#pragma unroll
    for (int a = 0; a < 2; ++a)
#pragma unroll
        for (int b = 0; b < 2; ++b)
#pragma unroll
            for (int m = 0; m < 4; ++m)
#pragma unroll
                for (int n = 0; n < 2; ++n) acc[a][b][m][n] = (f32x4){0.f, 0.f, 0.f, 0.f};
    bf16x8 At[4][2], B0[2][2], B1[2][2];
    unsigned cA = g.a_off(cur), cB = g.b_off(cur);
    if constexpr (SP2) {
        PG8_STAGE(PG8_SB(0, 0), rsB, cB, voffB); PG8_STAGE(PG8_SB(0, 1), rsB, cB + hstepB, voffB); PG8_STAGE(PG8_SA(0, 0), rsA, cA, voffA); PG8_STAGE(PG8_SA(0, 1), rsA, cA + hstepA, voffA);
        if (wr == 1) PG8_BAR;
        PG8_WAIT_V(2); PG8_BAR;
        PG8_STAGE(PG8_SB(1, 0), rsB, cB + kstep, voffB); PG8_STAGE(PG8_SA(1, 0), rsA, cA + kstep, voffA); PG8_STAGE(PG8_SB(1, 1), rsB, cB + hstepB + kstep, voffB);
        PG8_WAIT_V(6); PG8_BAR;
    } else {
        PG8_STAGE(PG8_SB(0, 0), rsB, cB, voffB); PG8_STAGE(PG8_SA(0, 0), rsA, cA, voffA); PG8_STAGE(PG8_SB(0, 1), rsB, cB + hstepB, voffB); PG8_STAGE(PG8_SA(0, 1), rsA, cA + hstepA, voffA);
        if (wr == 1) PG8_BAR;
        PG8_WAIT_V(4); PG8_BAR;
        PG8_STAGE(PG8_SB(1, 0), rsB, cB + kstep, voffB); PG8_STAGE(PG8_SA(1, 0), rsA, cA + kstep, voffA); PG8_STAGE(PG8_SB(1, 1), rsB, cB + hstepB + kstep, voffB);
        PG8_WAIT_V(6); PG8_BAR;
    }
    for (;;) {
        const bool has_next = S.next(ui + 1, nxt);
        const unsigned nA = has_next ? g.a_off(nxt) : cA, nB = has_next ? g.b_off(nxt) : cB;
        for (int t = 0; t < nt; t += 2) {
            const bool last = (t == nt - 2);
            const unsigned a1 = cA + (unsigned)(t + 1) * kstep;
            const unsigned a2 = last ? nA : cA + (unsigned)(t + 2) * kstep, b2 = last ? nB : cB + (unsigned)(t + 2) * kstep;
            const unsigned a3 = a2 + kstep, b3 = b2 + kstep;
            if constexpr (SP2) {
            PG8_LDB(B0, 0, 0); PG8_LDB(B1, 0, 1); PG8_SCHED; PG8_LDA(At, 0, 0); PG8_STAGE(PG8_SA(1, 1), rsA, a1 + hstepA, voffA);
            PG8_WAIT_V(8); PG8_WAIT_L(0); PG8_BAR; PG8_MMA(0, 0, At, B0); PG8_MMA(0, 1, At, B1); PG8_BAR; PG8_SCHED;
            PG8_LDA(At, 0, 1); PG8_STAGE(PG8_SB(0, 0), rsB, b2, voffB); PG8_STAGE(PG8_SB(0, 1), rsB, b2 + hstepB, voffB); PG8_STAGE(PG8_SA(0, 0), rsA, a2, voffA);
            PG8_WAIT_V(8); PG8_WAIT_L(0); PG8_BAR; PG8_MMA(1, 0, At, B0); PG8_MMA(1, 1, At, B1); PG8_BAR; PG8_SCHED;
            PG8_LDB(B0, 1, 0); PG8_LDB(B1, 1, 1); PG8_SCHED; PG8_LDA(At, 1, 0); PG8_STAGE(PG8_SA(0, 1), rsA, a2 + hstepA, voffA);
            PG8_WAIT_V(8); PG8_WAIT_L(0); PG8_BAR; PG8_MMA(0, 0, At, B0); PG8_MMA(0, 1, At, B1); PG8_BAR; PG8_SCHED;
            PG8_LDA(At, 1, 1); PG8_STAGE(PG8_SB(1, 0), rsB, b3, voffB); PG8_STAGE(PG8_SB(1, 1), rsB, b3 + hstepB, voffB); PG8_STAGE(PG8_SA(1, 0), rsA, a3, voffA);
            PG8_WAIT_V(8); PG8_WAIT_L(0); PG8_BAR; PG8_MMA(1, 0, At, B0); PG8_MMA(1, 1, At, B1); PG8_BAR; PG8_SCHED;
            } else {
            PG8_LDB(B0, 0, 0); PG8_SCHED; PG8_LDA(At, 0, 0); PG8_STAGE(PG8_SA(1, 1), rsA, a1 + hstepA, voffA);
            PG8_WAIT_L(8); PG8_BAR; PG8_WAIT_L(0); PG8_MMA(0, 0, At, B0); PG8_BAR; PG8_SCHED;
            PG8_LDB(B1, 0, 1); PG8_STAGE(PG8_SB(0, 0), rsB, b2, voffB);
            PG8_BAR; PG8_WAIT_L(0); PG8_MMA(0, 1, At, B1); PG8_BAR;
            PG8_LDA(At, 0, 1); PG8_STAGE(PG8_SA(0, 0), rsA, a2, voffA);
            PG8_BAR; PG8_WAIT_L(0); PG8_MMA(1, 0, At, B0); PG8_BAR; PG8_SCHED;
            PG8_STAGE(PG8_SB(0, 1), rsB, b2 + hstepB, voffB);
            PG8_WAIT_V(6); PG8_BAR; PG8_MMA(1, 1, At, B1); PG8_BAR;
            PG8_LDB(B0, 1, 0); PG8_SCHED; PG8_LDA(At, 1, 0); PG8_STAGE(PG8_SA(0, 1), rsA, a2 + hstepA, voffA);
            PG8_WAIT_L(8); PG8_BAR; PG8_WAIT_L(0); PG8_MMA(0, 0, At, B0); PG8_BAR; PG8_SCHED;
            PG8_LDB(B1, 1, 1); PG8_STAGE(PG8_SB(1, 0), rsB, b3, voffB);
            PG8_BAR; PG8_WAIT_L(0); PG8_MMA(0, 1, At, B1); PG8_BAR;
            PG8_LDA(At, 1, 1); PG8_STAGE(PG8_SA(1, 0), rsA, a3, voffA);
            PG8_BAR; PG8_WAIT_L(0); PG8_MMA(1, 0, At, B0); PG8_BAR; PG8_SCHED;
            PG8_STAGE(PG8_SB(1, 1), rsB, b3 + hstepB, voffB);
            PG8_WAIT_V(6); PG8_BAR; PG8_MMA(1, 1, At, B1); PG8_BAR;
            }
        }
        if constexpr (ALIGN_EPI) { if (wr == 0) PG8_BAR; }
        { const int le = lane_id(); E(acc, cur, wr, wc, le & 15, le >> 4); }
        if (!has_next) break;
#pragma unroll
        for (int a = 0; a < 2; ++a)
#pragma unroll
            for (int b = 0; b < 2; ++b)
#pragma unroll
                for (int m = 0; m < 4; ++m)
#pragma unroll
                    for (int n = 0; n < 2; ++n) acc[a][b][m][n] = (f32x4){0.f, 0.f, 0.f, 0.f};
        cur = nxt; cA = nA; cB = nB; ++ui;
        if constexpr (ALIGN_EPI) { if (wr == 1) PG8_BAR; }
    }
    PG8_WAIT_V(0);
    if constexpr (!ALIGN_EPI) { if (wr == 0) PG8_BAR; }
    PG8_BAR;
#undef PG8_SA
#undef PG8_SB
#undef PG8_STAGE
#undef PG8_LDA
#undef PG8_LDB
#undef PG8_MMA
#undef PG8_WAIT_V
#undef PG8_WAIT_L
#undef PG8_BAR
#undef PG8_SCHED
}
}

constexpr int LDS_BYTES = 148480, MISC_OFF = 147456;

#define XB_TMO      128
#define XB_XCNT(j)  (256  + 64 * (j))
#define XB_XSUB(j)  (1280 + 64 * (j))
#define XB_XGEN(j)  (2304 + 64 * (j))
#define XB_TOP      3328
#define XB_TOPGEN   3392
#define XCD_BAR_WORDS 3456
#define XB_SPIN_CAP (1u << 18)
__device__ __forceinline__ unsigned xb_ld(unsigned* p)              { return __hip_atomic_load(p, __ATOMIC_RELAXED, __HIP_MEMORY_SCOPE_AGENT); }
__device__ __forceinline__ unsigned xb_add(unsigned* p, unsigned v) { return __hip_atomic_fetch_add(p, v, __ATOMIC_RELAXED, __HIP_MEMORY_SCOPE_AGENT); }
__device__ __forceinline__ unsigned xb_xcc_id() { return (unsigned)__builtin_amdgcn_s_getreg((3 << 11) | 20) & 0xFu; }
#define XB_SPIN(cond, bar) do { unsigned _sp = 0; while (cond) { __builtin_amdgcn_s_sleep(1); \
    if ((++_sp & 255u) == 0u) { if (xb_ld(&(bar)[XB_TMO])) break; if (_sp > XB_SPIN_CAP) { atomicAdd(&(bar)[XB_TMO], 1u); break; } } } } while (0)
struct XcdBarrier { unsigned* bar; unsigned x; volatile LAS unsigned* st; };
__device__ __forceinline__ XcdBarrier xcd_barrier_post(unsigned* bar, volatile LAS unsigned* st) {
    XcdBarrier b; b.bar = bar; b.x = xb_xcc_id(); b.st = st;
    if (threadIdx.x == 0) (void)xb_add(&bar[XB_XCNT(b.x)], 1u);
    return b;
}
__device__ __forceinline__ void xcd_barrier_complete(unsigned* bar, unsigned x, unsigned& nloc, unsigned& nx) {
    const unsigned G = gridDim.x * gridDim.y * gridDim.z;
    unsigned sum, cnt, mine, sp = 0u;
    for (;;) {
        sum = 0u; cnt = 0u; mine = 0u;
#pragma unroll
        for (unsigned j = 0; j < 16; ++j) { const unsigned c = xb_ld(&bar[XB_XCNT(j)]); sum += c; cnt += (c > 0u) ? 1u : 0u; mine = (j == x) ? c : mine; }
        if (sum == G) break;
        __builtin_amdgcn_s_sleep(1);
        if ((++sp & 255u) == 0u) { if (xb_ld(&bar[XB_TMO])) break; if (sp > XB_SPIN_CAP) { atomicAdd(&bar[XB_TMO], 1u); break; } }
    }
    nloc = mine > 0u ? mine : 1u; nx = cnt > 0u ? cnt : 1u;
}
__device__ __forceinline__ void xcd_barrier(const XcdBarrier& b, int wv) {
    asm volatile("" : "+s"(wv));
    asm volatile("s_waitcnt vmcnt(0)" ::: "memory");
    __syncthreads();
    if (wv == 0 && lane_id() == 0) {
        unsigned* bar = b.bar;
        __builtin_amdgcn_s_waitcnt(0);
        unsigned nloc = b.st[0], nx = b.st[1];
        if (nloc == 0u) { xcd_barrier_complete(bar, b.x, nloc, nx); b.st[0] = nloc; b.st[1] = nx; }
        const unsigned old = xb_add(&bar[XB_XSUB(b.x)], 1u);
        const unsigned gen = old / nloc;
        if (old + 1u == (gen + 1u) * nloc) {
            __builtin_amdgcn_fence(__ATOMIC_RELEASE, "agent");
            asm volatile("s_waitcnt vmcnt(0)" ::: "memory");
            const unsigned og = xb_add(&bar[XB_TOP], 1u);
            const unsigned tg = og / nx;
            if (og + 1u == (tg + 1u) * nx) xb_add(&bar[XB_TOPGEN], 1u);
            else XB_SPIN(xb_ld(&bar[XB_TOPGEN]) == tg, bar);
            __builtin_amdgcn_fence(__ATOMIC_ACQUIRE, "agent");
            xb_add(&bar[XB_XGEN(b.x)], 1u);
            asm volatile("s_waitcnt vmcnt(0)" ::: "memory");
        } else {
            XB_SPIN(xb_ld(&bar[XB_XGEN(b.x)]) == gen, bar);
            __builtin_amdgcn_fence(__ATOMIC_ACQUIRE, "agent");
            asm volatile("s_waitcnt vmcnt(0)" ::: "memory");
        }
    }
    __syncthreads();
}

template <int NC> __device__ __forceinline__ void tr_load(const float* W, int N, int k0, int n0, f32x4 (&x)[NC][4], int lane) {
    const int i = lane & 15, fq = lane >> 4; const int k1 = k0 + 8 * (i >> 2) + (i & 3), k2 = k1 + 4;
    const float* p1 = W + (size_t)k1 * N + n0 + 8 * fq; const float* p2 = W + (size_t)k2 * N + n0 + 8 * fq;
#pragma unroll
    for (int c = 0; c < NC; ++c) { x[c][0] = *(const f32x4*)(p1 + 32 * c); x[c][1] = *(const f32x4*)(p1 + 32 * c + 4); x[c][2] = *(const f32x4*)(p2 + 32 * c); x[c][3] = *(const f32x4*)(p2 + 32 * c + 4); }
}
template <int NC> __device__ __forceinline__ void tr_finish(bf16_t* WT, int ldk, int k0, int drow0, const float* gain, const f32x4 (&x)[NC][4], int lane) {
    const int i = lane & 15, fq = lane >> 4; const int k1 = k0 + 8 * (i >> 2) + (i & 3), k2 = k1 + 4;
    const float g1 = gain ? gain[k1] : 1.0f, g2 = gain ? gain[k2] : 1.0f;
    u32x4 s0, s1;
    { unsigned e0[8], e1[8];
#pragma unroll
      for (int e = 0; e < 8; ++e) { e0[e] = (8 * fq + e == i) ? 0x3F80u : 0u; e1[e] = (8 * fq + e == 16 + i) ? 0x3F80u : 0u; }
      s0 = (u32x4){e0[0] | (e0[1] << 16), e0[2] | (e0[3] << 16), e0[4] | (e0[5] << 16), e0[6] | (e0[7] << 16)}; s1 = (u32x4){e1[0] | (e1[1] << 16), e1[2] | (e1[3] << 16), e1[4] | (e1[5] << 16), e1[6] | (e1[7] << 16)}; }
    const bf16x8 I0 = __builtin_bit_cast(bf16x8, s0), I1 = __builtin_bit_cast(bf16x8, s1);
    const f32x4 z = (f32x4){0.f, 0.f, 0.f, 0.f};
#pragma unroll
    for (int c = 0; c < NC; ++c) { const bf16x8 A1 = __builtin_bit_cast(bf16x8, pg8::pack8(x[c][0] * g1, x[c][1] * g1)), A2 = __builtin_bit_cast(bf16x8, pg8::pack8(x[c][2] * g2, x[c][3] * g2));
        const f32x4 d00 = __builtin_amdgcn_mfma_f32_16x16x32_bf16(A1, I0, z, 0, 0, 0), d01 = __builtin_amdgcn_mfma_f32_16x16x32_bf16(A2, I0, z, 0, 0, 0);
        const f32x4 d10 = __builtin_amdgcn_mfma_f32_16x16x32_bf16(A1, I1, z, 0, 0, 0), d11 = __builtin_amdgcn_mfma_f32_16x16x32_bf16(A2, I1, z, 0, 0, 0);
        *(u32x4*)(WT + (size_t)(drow0 + 32 * c + i) * ldk + k0 + 8 * fq) = pg8::pack8(d00, d01);
        *(u32x4*)(WT + (size_t)(drow0 + 32 * c + 16 + i) * ldk + k0 + 8 * fq) = pg8::pack8(d10, d11); }
}
template <int NC> __device__ __forceinline__ void tr_mfma(const float* W, int N, bf16_t* WT, int ldk, int k0, int n0, int drow0, const float* gain, int lane) {
    f32x4 x[NC][4]; tr_load<NC>(W, N, k0, n0, x, lane); tr_finish<NC>(WT, ldk, k0, drow0, gain, x, lane);
}

struct Args { const float* in[37]; float* out; unsigned char* ws; int ph_lo, ph_hi, use_bar, pad; };
typedef __attribute__((address_space(4))) const Args* KArgs;
__device__ __forceinline__ KArgs kargs() { KArgs p = (KArgs)__builtin_amdgcn_kernarg_segment_ptr(); asm volatile("" : "+s"(p)); return p; }
enum { I_X = 0, I_P, I_NORMS, I_FNORM, I_WG, I_WU, I_WDN, I_PWP, I_PWG, I_EIN, I_EOUT, I_AVN, I_AWS, I_ABS, I_BON, I_BLB, I_CMIX, I_CWR, I_CWK, I_CWV, I_CWO,
       I_CW0, I_CW1, I_CW2, I_CA0, I_CA1, I_CA2, I_CG1, I_CG2, I_CKK, I_CKA, I_CRK, I_CGNG, I_CGNB, I_CV0, I_CV1, I_CV2 };

struct CJob { int in_idx; unsigned src_off; int N; unsigned long long dst_off; int ldk; int nblk; int nc; int mode  ; int rowoff; int gain_off; int end; };
constexpr int NJOBS = 51;
struct CJobTable { CJob j[NJOBS]; int n; };
constexpr CJob mk_job(int in_idx, unsigned src_off, int K, int N, unsigned long long dst_off, int ldk, int nc, int mode, int rowoff, int gain_off) {
    return CJob{in_idx, src_off, N, dst_off, ldk, N / (32 * nc), nc, mode, rowoff, gain_off, (K / 32) * (N / (32 * nc))}; }
constexpr void add_gu(CJobTable& t, int m) {
    const int gain = ((m >> 1) * 4 + ((m & 1) ? 2 : 0)) * D;
    t.j[t.n++] = mk_job(4, (unsigned)m * D * FF, D, FF, WS_WGU + (unsigned long long)m * 2 * FF * D * 2, D, 2, 1, 0, gain);
    t.j[t.n++] = mk_job(5, (unsigned)m * D * FF, D, FF, WS_WGU + (unsigned long long)m * 2 * FF * D * 2, D, 2, 2, 0, gain); }
constexpr void add_dn(CJobTable& t, int m) { t.j[t.n++] = mk_job(6, (unsigned)m * FF * D, FF, D, WS_WD + (unsigned long long)m * D * FF * 2, FF, 2, 0, 0, -1); }
constexpr void add_ffn(CJobTable& t, int m) { add_gu(t, m); add_dn(t, m); }
constexpr void add_ple(CJobTable& t, int l) {
    t.j[t.n++] = mk_job(7, (unsigned)l * PLE * D, PLE, D, WS_WPP + (unsigned long long)l * D * PLE * 2, PLE, 2, 0, 0, -1);
    t.j[t.n++] = mk_job(8, (unsigned)l * D * D, D, D, WS_WPG + (unsigned long long)l * D * D * 2, D, 2, 0, 0, (l * 4 + 3) * D); }
constexpr void add_even(CJobTable& t, int jj) {
    t.j[t.n++] = mk_job(9, (unsigned)jj * D * EIN, D, EIN, WS_WEIN + (unsigned long long)jj * EIN * D * 2, D, 2, 0, 0, (jj * 8 + 1) * D);
    t.j[t.n++] = mk_job(10, (unsigned)jj * D * D, D, D, WS_WEOUT + (unsigned long long)jj * D * D * 2, D, 2, 0, 0, -1); }
constexpr void add_rin(CJobTable& t, int jj) {
    const unsigned long long dst = WS_WRIN + (unsigned long long)jj * RIN_N * D * 2;
    t.j[t.n++] = mk_job(17, (unsigned)jj * D * D, D, D, dst, D, 2, 0, 0, -1);
    t.j[t.n++] = mk_job(18, (unsigned)jj * D * D, D, D, dst, D, 2, 0, D, -1);
    t.j[t.n++] = mk_job(19, (unsigned)jj * D * D, D, D, dst, D, 2, 0, 2 * D, -1);
    t.j[t.n++] = mk_job(22, (unsigned)jj * D * 96, D, 96, dst, D, 1, 0, 6144, -1);
    t.j[t.n++] = mk_job(25, (unsigned)jj * D * 96, D, 96, dst, D, 1, 0, 6400, -1);
    t.j[t.n++] = mk_job(27, (unsigned)jj * D * 256, D, 256, dst, D, 2, 0, 6656, -1);
    if (jj == 1) t.j[t.n++] = mk_job(35, 0u, D, 64, dst, D, 2, 0, 6912, -1); }
constexpr void add_wo(CJobTable& t, int jj) { t.j[t.n++] = mk_job(20, (unsigned)jj * D * D, D, D, WS_WO + (unsigned long long)jj * D * D * 2, D, 2, 0, 0, -1); }
constexpr int N_STAGE_A_JOBS = 2 + 2 + 2 + 2 + 2 + 6;
constexpr CJobTable make_jobs() {
    CJobTable t{}; t.n = 0;
    add_gu(t, 0); add_even(t, 0); add_gu(t, 1); add_ple(t, 0); add_gu(t, 2); add_rin(t, 0);
    add_dn(t, 0); add_dn(t, 1); add_dn(t, 2);
    add_wo(t, 0); add_ffn(t, 3); add_ple(t, 1);
    add_ffn(t, 4); add_even(t, 1); add_ffn(t, 5); add_ple(t, 2);
    add_ffn(t, 6); add_rin(t, 1);
    add_wo(t, 1); add_ffn(t, 7); add_ple(t, 3);
    int acc = 0; for (int i = 0; i < t.n; ++i) { acc += t.j[i].end; t.j[i].end = acc; }
    return t; }
constexpr CJobTable CJT_H = make_jobs();
static_assert(CJT_H.n == NJOBS, "job count");
constexpr int CV_A = CJT_H.j[N_STAGE_A_JOBS - 1].end, CV_ALL = CJT_H.j[NJOBS - 1].end;
__device__ const CJobTable CJT = make_jobs();
constexpr int CVQ_TAIL = (FF / 32) * (D / 64), CVQ_N = 8;
constexpr int CVQ_LATE = (CV_ALL - CV_A - 3 * CVQ_TAIL) > 0 ? 0 : 0;
constexpr int cvq_end(int k) {
    const int total = CV_ALL - CV_A;
    return k < 3 ? (k + 1) * CVQ_TAIL : (k == 3 ? 85576 : (k == 4 ? 90076 : (k == 5 ? 95876 : (k == 6 ? 100376 : (k == 7 ? 106176 : (k == 8 ? total - 2048 : total)))))); }
static_assert(CV_ALL - CV_A == 127424 && CJT_H.j[N_STAGE_A_JOBS + 2].end - CV_A == 3 * CVQ_TAIL && (cvq_end(3) - cvq_end(2) + 1023) / 1024 <= 68 && (cvq_end(8) - cvq_end(7) + 1023) / 1024 <= 64 && cvq_end(9) == CV_ALL - CV_A, "conversion quotas");

struct TrDesc { const float* W; bf16_t* WT; const float* gain; int N, ldk, k0, n0, drow, nc, mode, rowoff, jend; };
__device__ __forceinline__ TrDesc tr_decode(int it) {
    KArgs ap = kargs();
    int jb = 0;
#pragma unroll 1
    for (int stp = 32; stp >= 1; stp >>= 1) { const int c = jb + stp; if (c < NJOBS && CJT.j[c - 1].end <= it) jb = c; }
    const CJob J = CJT.j[jb]; const int item = it - (jb ? CJT.j[jb - 1].end : 0);
    const int kb = item / J.nblk, nb = item % J.nblk; const int n0 = nb * 32 * J.nc;
    TrDesc d; d.W = ap->in[J.in_idx] + J.src_off; d.WT = (bf16_t*)(ap->ws + J.dst_off); d.gain = J.gain_off >= 0 ? ap->in[2] + J.gain_off : nullptr;
    d.N = J.N; d.ldk = J.ldk; d.k0 = 32 * kb; d.n0 = n0; d.drow = J.mode == 0 ? J.rowoff + n0 : 256 * (n0 >> 7) + (n0 & 127) + (J.mode == 2 ? 128 : 0); d.nc = J.nc; d.mode = J.mode; d.rowoff = J.rowoff; d.jend = J.end;
    return d;
}
__device__ __forceinline__ void tr_next(TrDesc& d, int it) {
    if (it >= d.jend) { d = tr_decode(it); return; }
    d.n0 += 32 * d.nc; if (d.n0 >= d.N) { d.n0 = 0; d.k0 += 32; }
    d.drow = d.mode == 0 ? d.rowoff + d.n0 : 256 * (d.n0 >> 7) + (d.n0 & 127) + (d.mode == 2 ? 128 : 0);
}
__device__ __forceinline__ void convert_items(int lo, int hi, int gw, int NGW, int lane) {
    for (int it = lo + gw; it < hi; it += NGW) { const TrDesc d = tr_decode(it);
        if (d.nc == 2) tr_mfma<2>(d.W, d.N, d.WT, d.ldk, d.k0, d.n0, d.drow, d.gain, lane); else tr_mfma<1>(d.W, d.N, d.WT, d.ldk, d.k0, d.n0, d.drow, d.gain, lane); }
}

__device__ __forceinline__ void prologue(LAS unsigned char* lds, int G, int wv) {
    KArgs ap = kargs();
#define a (*ap)
    asm volatile("" : "+s"(wv)); int tid = TID_FROM_WAVE(wv);
    const int lane = tid & 63, wave = wv;
    unsigned char* ws = a.ws;
    int bid = blockIdx.x; asm volatile("" : "+s"(bid), "+s"(G)); const int gw = bid * NWAVES + wave, NGW = G * NWAVES;
    convert_items(0, CV_A, gw, NGW, lane);
    const size_t gt = (size_t)bid * NTHR + tid, GT = (size_t)G * NTHR;
    for (size_t i = gt; i < (size_t)16 * M / 4; i += GT) *(u32x4*)((float*)(ws + WS_SS) + M + i * 4) = (u32x4){0u, 0u, 0u, 0u};
    for (size_t i = gt; i < XG_BYTES / 16; i += GT) *(u32x4*)(ws + WS_XG + i * 16) = (u32x4){0u, 0u, 0u, 0u};
    for (size_t i = gt; i < (size_t)2 * 512 * (D / 8); i += GT) { const int mat = (int)(i / (512 * (D / 8))); const int rr = (int)(i % (512 * (D / 8))); const int pr = rr / (D / 8), ck = rr % (D / 8);
        const int row = pr < 160 ? 6240 + pr : (pr < 320 ? 6496 + (pr - 160) : 6976 + (pr - 320));
        *(u32x4*)((bf16_t*)(ws + WS_WRIN) + ((size_t)mat * RIN_N + row) * D + ck * 8) = (u32x4){0u, 0u, 0u, 0u}; }
    for (size_t i = gt; i < (size_t)2 * 8192 * 32; i += GT) { const int mat = (int)(i / (8192 * 32)); const int rr = (int)(i % (8192 * 32)); const int ko = rr / 8192, n = rr % 8192; const int grp = n >> 11, nn = n & 2047;
        const float* src; int ks;
        if (grp == 0) { src = a.in[I_CW2] + (size_t)mat * 96 * D; ks = 96; } else if (grp == 1) { src = a.in[I_CA2] + (size_t)mat * 96 * D; ks = 96; }
        else if (grp == 2) { src = a.in[I_CG2] + (size_t)mat * 256 * D; ks = 256; } else { src = a.in[I_CV2]; ks = mat == 1 ? 64 : 0; }
        float v[8];
#pragma unroll
        for (int q = 0; q < 8; ++q) { const int k = ko * 8 + q; v[q] = k < ks ? src[(size_t)k * D + nn] : 0.f; }
        u32x4 o; o.x = cvt_pk_bf16(v[0], v[1]); o.y = cvt_pk_bf16(v[2], v[3]); o.z = cvt_pk_bf16(v[4], v[5]); o.w = cvt_pk_bf16(v[6], v[7]);
        *(u32x4*)((bf16_t*)(ws + WS_WL2) + ((size_t)mat * 8192 + n) * 256 + ko * 8) = o; }
    for (size_t i = gt; i < (size_t)DEPTH * M * PLE / 8; i += GT) { const f32x4 x0 = *(const f32x4*)(a.in[I_P] + i * 8), x1 = *(const f32x4*)(a.in[I_P] + i * 8 + 4);
        *(u32x4*)((bf16_t*)(ws + WS_PB) + i * 8) = pg8::pack8(x0, x1); }
    for (size_t i = gt; i < 1024; i += GT) { const float* lg = a.in[I_BLB]; const float l0 = lg[i], l1 = lg[1024 + i], l2 = lg[2048 + i], l3 = lg[3072 + i];
        const float mx = fmaxf(fmaxf(l0, l1), fmaxf(l2, l3)); const float e0 = expf_(l0 - mx), e1 = expf_(l1 - mx), e2 = expf_(l2 - mx), e3 = expf_(l3 - mx); const float inv = 1.0f / (e0 + e1 + e2 + e3);
        float* lb = (float*)(ws + WS_LB); lb[i] = 0.f; lb[1024 + i] = e1 * inv; lb[2048 + i] = (e1 + e2) * inv; lb[3072 + i] = (e1 + e2 + e3) * inv; }
    for (size_t i = gt; i < (size_t)2 * 4 * D; i += GT) { const int jj = (int)(i / (4 * D)), g4 = (int)((i / D) & 3), c = (int)(i % D);
        float v = 0.f; if (g4 == 0) v = a.in[I_CW0][jj * D + c]; else if (g4 == 1) v = a.in[I_CA0][jj * D + c]; else if (g4 == 3) v = a.in[I_CV0][c];
        ((float*)(ws + WS_LBIAS))[i] = v; }
    for (int row = gw; row < M; row += NGW) { const float* xr = a.in[I_X] + (size_t)row * D; unsigned char* lr = ws + WS_H + (size_t)row * D; bf16_t* br = (bf16_t*)(ws + WS_HB1) + (size_t)row * D; float s = 0.f;
#pragma unroll
        for (int j = 0; j < 4; ++j) { const int c = (j * 64 + lane) * 8; const f32x4 x0 = *(const f32x4*)(xr + c), x1 = *(const f32x4*)(xr + c + 4);
            { const u32x4 hi = pg8::pack8(x0, x1); f32x4 r0, r1; pg8::unpack8(hi, r0, r1); *(u32x4*)(br + c) = hi; u32x2 lq; lq.x = lo8_pack(lo8_enc(x0[0], r0[0]), lo8_enc(x0[1], r0[1]), lo8_enc(x0[2], r0[2]), lo8_enc(x0[3], r0[3])); lq.y = lo8_pack(lo8_enc(x1[0], r1[0]), lo8_enc(x1[1], r1[1]), lo8_enc(x1[2], r1[2]), lo8_enc(x1[3], r1[3])); *(u32x2*)(lr + c) = lq; }
            s += (x0[0] * x0[0] + x0[1] * x0[1]) + (x0[2] * x0[2] + x0[3] * x0[3]) + (x1[0] * x1[0] + x1[1] * x1[1]) + (x1[2] * x1[2] + x1[3] * x1[3]); }
        s = wave_sum(s); if (lane == 0) ((float*)(ws + WS_SS))[row] = s; }
}

#undef a
__device__ __forceinline__ f32x4 bf4(const u32x2 w) { f32x4 o; o[0] = bf2f(w.x & 0xffffu); o[1] = bf2f(w.x >> 16); o[2] = bf2f(w.y & 0xffffu); o[3] = bf2f(w.y >> 16); return o; }
__device__ __forceinline__ f32x4 hl4(const u32x2 hi, unsigned lo) { f32x4 o = bf4(hi); o[0] += lo8_dec(o[0], lo, 0); o[1] += lo8_dec(o[1], lo, 1); o[2] += lo8_dec(o[2], lo, 2); o[3] += lo8_dec(o[3], lo, 3); return o; }
__device__ __forceinline__ void hgrn_p2(int G, int wv) {
    asm volatile("" : "+s"(wv));
    KArgs ap = kargs();
#define a (*ap)
    bf16_t* U = (bf16_t*)(a.ws + WS_U); const float* DC = (const float*)(a.ws + WS_DC);
    int bid = blockIdx.x; asm volatile("" : "+s"(bid), "+s"(G)); const size_t gt = (size_t)bid * NTHR + TID_FROM_WAVE(wv), GT = (size_t)G * NTHR;
    for (size_t e = gt; e < (size_t)32 * 4096; e += GT) { const int bh = (int)(e >> 12), kv = (int)(e & 4095) * 4, k = kv >> 7; f32x4 S = (f32x4){0.f, 0.f, 0.f, 0.f};
        u32x2 uv[32]; float dcv[32];
#pragma unroll
        for (int c = 0; c < 32; ++c) { uv[c] = *(const u32x2*)(U + ((size_t)(bh * 32 + c) << 14) + kv); dcv[c] = DC[(size_t)(bh * 32 + c) * 128 + k]; }
#pragma unroll
        for (int c = 0; c < 32; ++c) { const size_t idx = ((size_t)(bh * 32 + c) << 14) + kv;
            u32x2 o; o.x = cvt_pk_bf16(S[0], S[1]); o.y = cvt_pk_bf16(S[2], S[3]); *(u32x2*)(U + idx) = o; S = S * dcv[c] + bf4(uv[c]); } }
}
#undef a
#define MFMA16(a, b, c) __builtin_amdgcn_mfma_f32_16x16x32_bf16((a), (b), (c), 0, 0, 0)
__device__ __forceinline__ bf16_t bf1(float x) { return (bf16_t)(cvt_pk_bf16(x, 0.f) & 0xffffu); }
__device__ __forceinline__ void gmlp_unit(LAS unsigned char* lds, int unit, int j, int wv, bool reuse_w) {
    KArgs ap = kargs();
#define a (*ap)
    asm volatile("" : "+s"(wv)); int tid = TID_FROM_WAVE(wv);
    const int lane = tid & 63, fr = lane & 15, fq = lane >> 4;
    unsigned char* ws = a.ws;
    const int g = unit & 7, n = (unit >> 3) & 15, b = unit >> 7; const int row0 = b * SEQ + n * 128, c0 = g * 128;
    const bf16_t* EA = (const bf16_t*)(ws + WS_EA); bf16_t* AB = (bf16_t*)(ws + WS_AB);
    LAS bf16_t* Wt = (LAS bf16_t*)lds; LAS bf16_t* vgT = Wt + 128 * 136;
    u32x2 u2v[8]; float btv[8]; f32x4 g4v[8];
    {   const float* bs = a.in[I_ABS] + ((size_t)j * 8 + g) * 128; const int c = c0 + 16 * wv + 4 * fq; const float* gn = a.in[I_AVN] + (size_t)j * 1024 + c0 + (tid & 3) * 32;
#pragma unroll
        for (int tj = 0; tj < 8; ++tj) { const int t = 16 * tj + fr; btv[tj] = bs[t]; u2v[tj] = *(const u32x2*)(EA + (size_t)(row0 + t) * EIN + c); g4v[tj] = *(const f32x4*)(gn + tj * 4); } }
    if (!reuse_w) {
        const int t = tid >> 2, sq = (tid & 3) * 32; const float* src = a.in[I_AWS] + ((size_t)j * 8 + g) * 128 * 128 + t * 128 + sq;
#pragma unroll
        for (int q = 0; q < 4; ++q) { f32x4 x0 = *(const f32x4*)(src + q * 8), x1 = *(const f32x4*)(src + q * 8 + 4);
#pragma unroll
            for (int e = 0; e < 4; ++e) { if (sq + q * 8 + e > t) x0[e] = 0.f; if (sq + q * 8 + 4 + e > t) x1[e] = 0.f; }
            *(LAS u32x4*)(Wt + t * 136 + sq + q * 8) = pg8::pack8(x0, x1); }
    }
    {
        const int t = tid >> 2, cq = (tid & 3) * 32; const bf16_t* src = EA + (size_t)(row0 + t) * EIN + 1024 + c0 + cq; float x[32]; float s = 0.f;
#pragma unroll
        for (int q = 0; q < 4; ++q) { f32x4 p0, p1; pg8::unpack8(*(const u32x4*)(src + q * 8), p0, p1);
#pragma unroll
            for (int e = 0; e < 4; ++e) { x[q * 8 + e] = p0[e]; x[q * 8 + 4 + e] = p1[e]; s += p0[e] * p0[e] + p1[e] * p1[e]; } }
        s = red4(s); const float rs = __builtin_amdgcn_rsqf(s * (1.0f / 128.0f) + RMS_EPS);
#pragma unroll
        for (int q = 0; q < 8; ++q) { const f32x4 g4 = g4v[q];
#pragma unroll
            for (int e = 0; e < 4; ++e) vgT[(cq + q * 4 + e) * 136 + t] = bf1(x[q * 4 + e] * rs * g4[e]); }
    }
    __syncthreads();
    f32x4 acc[8];
#pragma unroll
    for (int tj = 0; tj < 8; ++tj) acc[tj] = (f32x4){0.f, 0.f, 0.f, 0.f};
#pragma unroll
    for (int ks = 0; ks < 4; ++ks) { const bf16x8 av = *(const LAS bf16x8*)(vgT + (16 * wv + fr) * 136 + 32 * ks + 8 * fq);
#pragma unroll
        for (int tj = 0; tj < 8; ++tj) if (tj >= 2 * ks) { const bf16x8 bv = *(const LAS bf16x8*)(Wt + (16 * tj + fr) * 136 + 32 * ks + 8 * fq); acc[tj] = MFMA16(av, bv, acc[tj]); } }
    {
        const int c = c0 + 16 * wv + 4 * fq;
#pragma unroll
        for (int tj = 0; tj < 8; ++tj) { const int t = 16 * tj + fr; const float bt = btv[tj]; const u32x2 u2 = u2v[tj];
            const float o0 = bf2f(u2.x & 0xffffu) * (acc[tj][0] + bt), o1 = bf2f(u2.x >> 16) * (acc[tj][1] + bt), o2 = bf2f(u2.y & 0xffffu) * (acc[tj][2] + bt), o3 = bf2f(u2.y >> 16) * (acc[tj][3] + bt);
            u32x2 w; w.x = cvt_pk_bf16(o0, o1); w.y = cvt_pk_bf16(o2, o3); *(u32x2*)(AB + (size_t)(row0 + t) * D + c) = w; }
    }
    __syncthreads();
}
#undef a

__device__ __forceinline__ void hgrn_cumsum(LAS float* cum, int tid) {
    __syncthreads();
    {
        LAS float* tot = cum + 137216 / 4; const int k = tid & 127, seg = tid >> 7; float v[16];
#pragma unroll
        for (int i = 0; i < 16; ++i) v[i] = cum[(16 * seg + i) * 136 + k];
#pragma unroll
        for (int i = 1; i < 16; ++i) v[i] += v[i - 1];
        tot[seg * 128 + k] = v[15];
        __syncthreads();
        float off = 0.f;
#pragma unroll
        for (int s2 = 0; s2 < 3; ++s2) if (s2 < seg) off += tot[s2 * 128 + k];
#pragma unroll
        for (int i = 0; i < 16; ++i) cum[(16 * seg + i) * 136 + k] = v[i] + off; }
    __syncthreads();}
__device__ __forceinline__ void hgrn_cum(const float* LOGF, int row0, int h, LAS float* cum, LAS bf16_t* kkb, int tid) {
#pragma unroll
    for (int i = 0; i < 4; ++i) { const int idx = (i * NTHR + tid) * 4; const int t = idx >> 7, k = idx & 127; const f32x4 v = *(const f32x4*)(LOGF + (size_t)(row0 + t) * 1024 + h * 128 + k);
        *(LAS f32x4*)(cum + t * 136 + k) = v;
        if (kkb) { u32x2 o; o.x = cvt_pk_bf16(1.0f - expf_(v[0]), 1.0f - expf_(v[1])); o.y = cvt_pk_bf16(1.0f - expf_(v[2]), 1.0f - expf_(v[3])); *(LAS u32x2*)(kkb + t * 136 + k) = o; } }
    hgrn_cumsum(cum, tid);
}
__device__ __forceinline__ void hgrn_p1_all(LAS unsigned char* lds, int wv) {
    KArgs ap = kargs();
#define a (*ap)
    asm volatile("" : "+s"(wv)); int tid = TID_FROM_WAVE(wv);
    const int lane = tid & 63, fr = lane & 15, fq = lane >> 4;
    unsigned char* ws = a.ws;
    int G = gridDim.x, bid = blockIdx.x; asm volatile("" : "+s"(G), "+s"(bid));
    const bf16_t* EA = (const bf16_t*)(ws + WS_EA); const float* LOGF = (const float*)(ws + WS_LOGF);
    LAS float* cum = (LAS float*)lds;
    LAS bf16_t* qb = (LAS bf16_t*)(lds + 34816);
    LAS bf16_t* kkb = (LAS bf16_t*)(lds + 52224);
    LAS bf16_t* Kd = (LAS bf16_t*)(lds + 69632);
    LAS bf16_t* KdZ = (LAS bf16_t*)(lds + 139264);
    LAS bf16_t* kdT = Kd;
    LAS bf16_t* ivT = (LAS bf16_t*)(lds + 108800);
    LAS bf16_t* att = (LAS bf16_t*)(lds + 127232);
    u32x4 Qv[2], Iv[2]; f32x4 Lv[4];
#define P1_LOAD(unit_) do { const int n_ = (unit_) & 31, h_ = ((unit_) >> 5) & 7, b_ = (unit_) >> 8; const int r0_ = b_ * SEQ + n_ * 64; \
        _Pragma("unroll") for (int i = 0; i < 2; ++i) { const int idx = (i * NTHR + tid) * 8; const bf16_t* p_ = EA + (size_t)(r0_ + (idx >> 7)) * EIN + h_ * 128 + (idx & 127); Qv[i] = *(const u32x4*)(p_ + 2048); Iv[i] = *(const u32x4*)(p_ + 4096); } \
        _Pragma("unroll") for (int i = 0; i < 4; ++i) { const int idx = (i * NTHR + tid) * 4; Lv[i] = *(const f32x4*)(LOGF + (size_t)(r0_ + (idx >> 7)) * 1024 + h_ * 128 + (idx & 127)); } } while (0)
    if (bid < 1024) P1_LOAD(bid);
#pragma unroll 1
    for (int unit = bid; unit < 1024; unit += G) {
    const int n = unit & 31, h = (unit >> 5) & 7, b = unit >> 8; const int row0 = b * SEQ + n * 64;
#pragma unroll
    for (int i = 0; i < 2; ++i) { const int idx = (i * NTHR + tid) * 8; const int t = idx >> 7, k = idx & 127;
        *(LAS u32x4*)(qb + t * 136 + k) = Qv[i];
        const u32x4 w = Iv[i];
        ivT[(k + 0) * 72 + t] = (bf16_t)(w.x & 0xffffu); ivT[(k + 1) * 72 + t] = (bf16_t)(w.x >> 16); ivT[(k + 2) * 72 + t] = (bf16_t)(w.y & 0xffffu); ivT[(k + 3) * 72 + t] = (bf16_t)(w.y >> 16);
        ivT[(k + 4) * 72 + t] = (bf16_t)(w.z & 0xffffu); ivT[(k + 5) * 72 + t] = (bf16_t)(w.z >> 16); ivT[(k + 6) * 72 + t] = (bf16_t)(w.w & 0xffffu); ivT[(k + 7) * 72 + t] = (bf16_t)(w.w >> 16); }
    for (int i = tid; i < 576; i += NTHR) *(LAS u32x4*)((LAS unsigned char*)att + i * 16) = (u32x4){0u, 0u, 0u, 0u};
#pragma unroll
    for (int i = 0; i < 4; ++i) { const int idx = (i * NTHR + tid) * 4; const int t = idx >> 7, k = idx & 127; const f32x4 v = Lv[i];
        *(LAS f32x4*)(cum + t * 136 + k) = v;
        u32x2 o; o.x = cvt_pk_bf16(1.0f - expf_(v[0]), 1.0f - expf_(v[1])); o.y = cvt_pk_bf16(1.0f - expf_(v[2]), 1.0f - expf_(v[3])); *(LAS u32x2*)(kkb + t * 136 + k) = o; }
    if (unit + G < 1024) P1_LOAD(unit + G);
    hgrn_cumsum(cum, tid);
#pragma unroll
    for (int i = 0; i < 4; ++i) { const int idx = i * NTHR + tid; const int t = idx >> 5, k = (idx & 31) * 4; const int I = t >> 4;
        const f32x4 ct = *(const LAS f32x4*)(cum + t * 136 + k); f32x4 cI = (f32x4){0.f, 0.f, 0.f, 0.f}; if (I > 0) cI = *(const LAS f32x4*)(cum + (16 * I - 1) * 136 + k);
        const u32x2 q2 = *(const LAS u32x2*)(qb + t * 136 + k);
        u32x2 o; o.x = cvt_pk_bf16(bf2f(q2.x & 0xffffu) * expf_(ct[0] - cI[0]), bf2f(q2.x >> 16) * expf_(ct[1] - cI[1])); o.y = cvt_pk_bf16(bf2f(q2.y & 0xffffu) * expf_(ct[2] - cI[2]), bf2f(q2.y >> 16) * expf_(ct[3] - cI[3]));
        *(LAS u32x2*)(qb + t * 136 + k) = o; }
#pragma unroll
    for (int i = 0; i < 10; ++i) { const int idx = i * NTHR + tid; const int rr = idx >> 5, k = (idx & 31) * 4; const int I = rr < 16 ? 0 : (rr < 48 ? 1 : (rr < 96 ? 2 : 3)); const int sidx = rr - (I == 0 ? 0 : (I == 1 ? 16 : (I == 2 ? 48 : 96)));
        const f32x4 cs = *(const LAS f32x4*)(cum + sidx * 136 + k); f32x4 cI = (f32x4){0.f, 0.f, 0.f, 0.f}; if (I > 0) cI = *(const LAS f32x4*)(cum + (16 * I - 1) * 136 + k);
        const u32x2 k2 = *(const LAS u32x2*)(kkb + sidx * 136 + k);
        u32x2 o; o.x = cvt_pk_bf16(bf2f(k2.x & 0xffffu) * expf_(fminf(cI[0] - cs[0], 80.f)), bf2f(k2.x >> 16) * expf_(fminf(cI[1] - cs[1], 80.f))); o.y = cvt_pk_bf16(bf2f(k2.y & 0xffffu) * expf_(fminf(cI[2] - cs[2], 80.f)), bf2f(k2.y >> 16) * expf_(fminf(cI[3] - cs[3], 80.f)));
        LAS bf16_t* dst = I == 0 ? KdZ + sidx * 136 + k : Kd + (rr - 16) * 136 + k; *(LAS u32x2*)dst = o; }
    __syncthreads();
    for (int tile = wv; tile < 10; tile += 8) { const int I = tile == 0 ? 0 : (tile < 3 ? 1 : (tile < 6 ? 2 : 3)); const int J = tile - (I == 0 ? 0 : (I == 1 ? 1 : (I == 2 ? 3 : 6)));
        const LAS bf16_t* kb = I == 0 ? KdZ : Kd + (I == 1 ? 0 : (I == 2 ? 32 : 80)) * 136;
        f32x4 c = (f32x4){0.f, 0.f, 0.f, 0.f};
#pragma unroll
        for (int ks = 0; ks < 4; ++ks) c = MFMA16(*(const LAS bf16x8*)(qb + (16 * I + fr) * 136 + 32 * ks + 8 * fq), *(const LAS bf16x8*)(kb + (16 * J + fr) * 136 + 32 * ks + 8 * fq), c);
#pragma unroll
        for (int r = 0; r < 4; ++r) att[(16 * I + 4 * fq + r) * 72 + 16 * J + fr] = bf1((J < I || fr <= 4 * fq + r) ? c[r] : 0.f); }
    __syncthreads();
    {
        f32x4 acc[4];
#pragma unroll
        for (int I = 0; I < 4; ++I) acc[I] = (f32x4){0.f, 0.f, 0.f, 0.f};
#pragma unroll
        for (int ks = 0; ks < 2; ++ks) { const bf16x8 av = *(const LAS bf16x8*)(ivT + (16 * wv + fr) * 72 + 32 * ks + 8 * fq);
#pragma unroll
            for (int I = 0; I < 4; ++I) if (32 * ks <= 16 * I + 15) acc[I] = MFMA16(av, *(const LAS bf16x8*)(att + (16 * I + fr) * 72 + 32 * ks + 8 * fq), acc[I]); }
        float* OI = (float*)(ws + WS_OI);
#pragma unroll
        for (int I = 0; I < 4; ++I) *(f32x4*)(OI + (size_t)(row0 + 16 * I + fr) * 1024 + h * 128 + 16 * wv + 4 * fq) = acc[I];
#pragma unroll
        for (int i = 0; i < 4; ++i) { const int idx = (i * NTHR + tid) * 4; const int sidx = idx >> 7, k = idx & 127; const f32x4 cs = *(const LAS f32x4*)(cum + sidx * 136 + k), cl = *(const LAS f32x4*)(cum + 63 * 136 + k); const u32x2 k2 = *(const LAS u32x2*)(kkb + sidx * 136 + k);
            kdT[(k + 0) * 72 + sidx] = bf1(bf2f(k2.x & 0xffffu) * expf_(cl[0] - cs[0])); kdT[(k + 1) * 72 + sidx] = bf1(bf2f(k2.x >> 16) * expf_(cl[1] - cs[1]));
            kdT[(k + 2) * 72 + sidx] = bf1(bf2f(k2.y & 0xffffu) * expf_(cl[2] - cs[2])); kdT[(k + 3) * 72 + sidx] = bf1(bf2f(k2.y >> 16) * expf_(cl[3] - cs[3])); }
    }
    __syncthreads();
    {
        f32x4 acc[8];
#pragma unroll
        for (int kt = 0; kt < 8; ++kt) acc[kt] = (f32x4){0.f, 0.f, 0.f, 0.f};
#pragma unroll
        for (int ks = 0; ks < 2; ++ks) { const bf16x8 av = *(const LAS bf16x8*)(ivT + (16 * wv + fr) * 72 + 32 * ks + 8 * fq);
#pragma unroll
            for (int kt = 0; kt < 8; ++kt) acc[kt] = MFMA16(av, *(const LAS bf16x8*)(kdT + (16 * kt + fr) * 72 + 32 * ks + 8 * fq), acc[kt]); }
        bf16_t* U = (bf16_t*)(ws + WS_U) + (size_t)unit * 16384;
#pragma unroll
        for (int kt = 0; kt < 8; ++kt) { u32x2 o; o.x = cvt_pk_bf16(acc[kt][0], acc[kt][1]); o.y = cvt_pk_bf16(acc[kt][2], acc[kt][3]); *(u32x2*)(U + (16 * kt + fr) * 128 + 16 * wv + 4 * fq) = o; }
        if (tid < 128) ((float*)(ws + WS_DC))[(size_t)unit * 128 + tid] = expf_(cum[63 * 136 + tid]);
    }
    __syncthreads();
    }
#undef P1_LOAD
}
#undef a
__device__ __forceinline__ void hgrn_p3_all(LAS unsigned char* lds, int j, int wv) {
    KArgs ap = kargs();
#define a (*ap)
    asm volatile("" : "+s"(wv)); int tid = TID_FROM_WAVE(wv);
    const int lane = tid & 63, fr = lane & 15, fq = lane >> 4;
    unsigned char* ws = a.ws;
    int G = gridDim.x, bid = blockIdx.x; asm volatile("" : "+s"(G), "+s"(bid));
    const bf16_t* EA = (const bf16_t*)(ws + WS_EA); const float* LOGF = (const float*)(ws + WS_LOGF); const float* OI = (const float*)(ws + WS_OI);
    LAS float* cum = (LAS float*)lds;
    LAS bf16_t* qd = (LAS bf16_t*)(lds + 34816);
    LAS bf16_t* SpT = (LAS bf16_t*)(lds + 52224);
    LAS float* part = (LAS float*)(lds + 87040);
    f32x4 Lv[4], Ov[4], on; u32x4 Uv[4], Qv[2]; u32x2 Gv[4];
#define P3_LOAD_A(unit_) do { const int n_ = (unit_) & 31, h_ = ((unit_) >> 5) & 7, b_ = (unit_) >> 8; const int r0_ = b_ * SEQ + n_ * 64; const bf16_t* U_ = (const bf16_t*)(ws + WS_U) + (size_t)(unit_) * 16384; \
        _Pragma("unroll") for (int i = 0; i < 4; ++i) Uv[i] = *(const u32x4*)(U_ + (i * NTHR + tid) * 8); \
        _Pragma("unroll") for (int i = 0; i < 4; ++i) { const int idx = (i * NTHR + tid) * 4; Lv[i] = *(const f32x4*)(LOGF + (size_t)(r0_ + (idx >> 7)) * 1024 + h_ * 128 + (idx & 127)); } \
        _Pragma("unroll") for (int i = 0; i < 2; ++i) { const int idx = (i * NTHR + tid) * 8; Qv[i] = *(const u32x4*)(EA + (size_t)(r0_ + (idx >> 7)) * EIN + 2048 + h_ * 128 + (idx & 127)); } } while (0)
#define P3_LOAD_B(unit_) do { const int n_ = (unit_) & 31, h_ = ((unit_) >> 5) & 7, b_ = (unit_) >> 8; const int r0_ = b_ * SEQ + n_ * 64; const int vc_ = h_ * 128 + 16 * wv + 4 * fq; \
        _Pragma("unroll") for (int tt = 0; tt < 4; ++tt) { Ov[tt] = *(const f32x4*)(OI + (size_t)(r0_ + 16 * tt + fr) * 1024 + vc_); Gv[tt] = *(const u32x2*)(EA + (size_t)(r0_ + 16 * tt + fr) * EIN + 5120 + vc_); } \
        on = *(const f32x4*)(a.in[I_BON] + (size_t)j * 1024 + vc_); } while (0)
    if (bid < 1024) { P3_LOAD_A(bid); P3_LOAD_B(bid); }
#pragma unroll 1
    for (int unit = bid; unit < 1024; unit += G) {
        const int n = unit & 31, h = (unit >> 5) & 7, b = unit >> 8; const int row0 = b * SEQ + n * 64; const bool more = unit + G < 1024;
#pragma unroll
        for (int i = 0; i < 4; ++i) { const int idx = (i * NTHR + tid) * 8; const int k = idx >> 7, v = idx & 127; const u32x4 x = Uv[i];
            SpT[(v + 0) * 136 + k] = (bf16_t)(x.x & 0xffffu); SpT[(v + 1) * 136 + k] = (bf16_t)(x.x >> 16); SpT[(v + 2) * 136 + k] = (bf16_t)(x.y & 0xffffu); SpT[(v + 3) * 136 + k] = (bf16_t)(x.y >> 16);
            SpT[(v + 4) * 136 + k] = (bf16_t)(x.z & 0xffffu); SpT[(v + 5) * 136 + k] = (bf16_t)(x.z >> 16); SpT[(v + 6) * 136 + k] = (bf16_t)(x.w & 0xffffu); SpT[(v + 7) * 136 + k] = (bf16_t)(x.w >> 16); }
#pragma unroll
        for (int i = 0; i < 4; ++i) { const int idx = (i * NTHR + tid) * 4; *(LAS f32x4*)(cum + (idx >> 7) * 136 + (idx & 127)) = Lv[i]; }
        hgrn_cumsum(cum, tid);
#pragma unroll
        for (int i = 0; i < 2; ++i) { const int idx = (i * NTHR + tid) * 8; const int t = idx >> 7, k = idx & 127; f32x4 p0, p1;
            pg8::unpack8(Qv[i], p0, p1);
            const f32x4 c0 = *(const LAS f32x4*)(cum + t * 136 + k), c1 = *(const LAS f32x4*)(cum + t * 136 + k + 4);
#pragma unroll
            for (int q = 0; q < 4; ++q) { p0[q] *= expf_(c0[q]); p1[q] *= expf_(c1[q]); }
            *(LAS u32x4*)(qd + t * 136 + k) = pg8::pack8(p0, p1); }
        if (more) P3_LOAD_A(unit + G);
        __syncthreads();
        f32x4 acc[4];
#pragma unroll
        for (int tt = 0; tt < 4; ++tt) acc[tt] = (f32x4){0.f, 0.f, 0.f, 0.f};
#pragma unroll
        for (int ks = 0; ks < 4; ++ks) { const bf16x8 av = *(const LAS bf16x8*)(SpT + (16 * wv + fr) * 136 + 32 * ks + 8 * fq);
#pragma unroll
            for (int tt = 0; tt < 4; ++tt) acc[tt] = MFMA16(av, *(const LAS bf16x8*)(qd + (16 * tt + fr) * 136 + 32 * ks + 8 * fq), acc[tt]); }
        const int vcol = h * 128 + 16 * wv + 4 * fq;
#pragma unroll
        for (int tt = 0; tt < 4; ++tt) { acc[tt] += Ov[tt];
            float sq = (acc[tt][0] * acc[tt][0] + acc[tt][1] * acc[tt][1]) + (acc[tt][2] * acc[tt][2] + acc[tt][3] * acc[tt][3]); sq += shfl_xor_f(sq, 16); sq += shfl_xor_f(sq, 32);
            if (fq == 0) part[wv * 64 + 16 * tt + fr] = sq; }
        __syncthreads();
#pragma unroll
        for (int tt = 0; tt < 4; ++tt) { const int t = 16 * tt + fr; float sq = 0.f;
#pragma unroll
            for (int w8 = 0; w8 < 8; ++w8) sq += part[w8 * 64 + t];
            const float rs = __builtin_amdgcn_rsqf(sq * (1.0f / 128.0f) + RMS_EPS);
            const u32x2 g2 = Gv[tt];
            u32x2 w; w.x = cvt_pk_bf16(acc[tt][0] * rs * on[0] * bf2f(g2.x & 0xffffu), acc[tt][1] * rs * on[1] * bf2f(g2.x >> 16)); w.y = cvt_pk_bf16(acc[tt][2] * rs * on[2] * bf2f(g2.y & 0xffffu), acc[tt][3] * rs * on[3] * bf2f(g2.y >> 16));
            *(u32x2*)((bf16_t*)(ws + WS_AB) + (size_t)(row0 + t) * D + 1024 + vcol) = w; }
        if (more) P3_LOAD_B(unit + G);
        __syncthreads();
    }
#undef P3_LOAD_A
#undef P3_LOAD_B
}
#undef a

__device__ __forceinline__ void rwkv_mix(int G, int L, int j, int wv) {
    KArgs ap = kargs();
#define a (*ap)
    asm volatile("" : "+s"(wv)); int tid = TID_FROM_WAVE(wv);
    const int lane = tid & 63, wave = wv;
    unsigned char* ws = a.ws; const bf16_t* h = (const bf16_t*)(ws + WS_HB0); const unsigned char* lo8 = ws + WS_H; const float* ss = (const float*)(ws + WS_SS) + (size_t)(4 * L + 1) * M;
    const float* gn = a.in[I_NORMS] + (size_t)(4 * L + 1) * D; const float* mix = a.in[I_CMIX] + (size_t)j * 6 * D; bf16_t* XM = (bf16_t*)(ws + WS_XM);
    int bid = blockIdx.x; asm volatile("" : "+s"(bid), "+s"(G)); const int gw = bid * NWAVES + wave, NGW = G * NWAVES;
    for (int row0 = gw * 4; row0 < M; row0 += NGW * 4) { const int t0 = row0 & (SEQ - 1);
        float rsv[5]; rsv[0] = t0 > 0 ? rstd_of(ss[row0 - 1]) : 0.f;
#pragma unroll
        for (int r = 0; r < 4; ++r) rsv[r + 1] = rstd_of(ss[row0 + r]);
        const bf16_t* hp = h + (size_t)(t0 > 0 ? row0 - 1 : row0) * D; const bf16_t* h0 = h + (size_t)row0 * D;
        u32x2 xr[2][5]; unsigned xl[2][5]; f32x4 cf[2][7]; const unsigned char* lp = lo8 + (size_t)(t0 > 0 ? row0 - 1 : row0) * D; const unsigned char* l0 = lo8 + (size_t)row0 * D;
#define MIX_LOAD(bf, q) do { const int c_ = ((q) * 64 + lane) * 4; xr[bf][0] = *(const u32x2*)(hp + c_); xl[bf][0] = *(const unsigned*)(lp + c_); _Pragma("unroll") for (int r = 0; r < 4; ++r) { xr[bf][r + 1] = *(const u32x2*)(h0 + (size_t)r * D + c_); xl[bf][r + 1] = *(const unsigned*)(l0 + (size_t)r * D + c_); } \
            cf[bf][0] = *(const f32x4*)(gn + c_); _Pragma("unroll") for (int s = 0; s < 6; ++s) cf[bf][s + 1] = *(const f32x4*)(mix + (size_t)s * D + c_); } while (0)
#define MIX_DO(bf, q) do { const int c = ((q) * 64 + lane) * 4; f32x4 xp = hl4(xr[bf][0], xl[bf][0]) * rsv[0] * cf[bf][0]; \
            _Pragma("unroll") for (int r = 0; r < 4; ++r) { const f32x4 x = hl4(xr[bf][r + 1], xl[bf][r + 1]) * rsv[r + 1] * cf[bf][0]; const f32x4 xx = xp - x; \
                _Pragma("unroll") for (int s = 0; s < 6; ++s) { const int slot = s == 0 ? 0 : (s == 1 ? 3 : (s == 2 ? 1 : (s == 3 ? 2 : s))); const f32x4 o = x + xx * cf[bf][s + 1]; \
                    u32x2 w; w.x = cvt_pk_bf16(o[0], o[1]); w.y = cvt_pk_bf16(o[2], o[3]); *(u32x2*)(XM + ((size_t)slot * M + row0 + r) * D + c) = w; } \
                xp = x; } } while (0)
        MIX_LOAD(0, 0);
#pragma unroll 1
        for (int q = 0; q < 8; q += 2) { MIX_LOAD(1, q + 1); MIX_DO(0, q); if (q + 2 < 8) MIX_LOAD(0, q + 2); MIX_DO(1, q + 1); }
#undef MIX_DO
#undef MIX_LOAD
    }
}
#undef a
constexpr int TC = 32;
struct ScanRaw { u32x2 r, k, v, e, av, g, f, vg; };
__device__ __forceinline__ void rwkv_scan_unit(LAS unsigned char* lds, int unit, int j, int wv) {
    KArgs ap = kargs();
#define a (*ap)
    asm volatile("" : "+s"(wv)); int tid = TID_FROM_WAVE(wv);
    unsigned char* ws = a.ws;
    const int hd = unit & 31, b = unit >> 5; const int cbase = hd * 64;
    const bf16_t* Rb = (const bf16_t*)(ws + WS_RKV); const bf16_t* Kb = Rb + (size_t)M * D; const bf16_t* Vb = j == 0 ? (const bf16_t*)(ws + WS_VF) : Rb + (size_t)2 * M * D;
    const bf16_t* VF = (const bf16_t*)(ws + WS_VF);
    const bf16_t* EW = (const bf16_t*)(ws + WS_WAGV); const bf16_t* Ab = EW + (size_t)M * D; const bf16_t* Gb = EW + (size_t)2 * M * D; const bf16_t* VG = EW + (size_t)3 * M * D;
    bf16_t* Y = (bf16_t*)(ws + WS_Y);
    constexpr int ARR = TC * 64, BUFW = 7 * ARR + 64;
    LAS float* L0 = (LAS float*)lds; LAS float* L_y = L0 + 2 * BUFW;
    const int pt = tid >> 4, pc = (tid & 15) * 4;
    const int sp = tid >> 4, sq = (tid & 15) * 4;
    const f32x4 kk4 = *(const f32x4*)(a.in[I_CKK] + (size_t)j * D + cbase + pc), ka4 = *(const f32x4*)(a.in[I_CKA] + (size_t)j * D + cbase + pc), rk4 = *(const f32x4*)(a.in[I_CRK] + (size_t)j * D + cbase + pc);
    const f32x4 gg4 = *(const f32x4*)(a.in[I_CGNG] + (size_t)j * D + cbase + pc), gb4 = *(const f32x4*)(a.in[I_CGNB] + (size_t)j * D + cbase + pc);
    const size_t grow0 = (size_t)(b * SEQ + pt) * D + cbase + pc;
#define SCAN_FETCH(raw, t0) do { const size_t gr_ = grow0 + (size_t)(t0) * D; (raw).r = *(const u32x2*)(Rb + gr_); (raw).k = *(const u32x2*)(Kb + gr_); (raw).v = *(const u32x2*)(Vb + gr_); (raw).e = *(const u32x2*)(EW + gr_); \
        (raw).av = *(const u32x2*)(Ab + gr_); (raw).g = *(const u32x2*)(Gb + gr_); if (j == 1) { (raw).f = *(const u32x2*)(VF + gr_); (raw).vg = *(const u32x2*)(VG + gr_); } } while (0)
#define SCAN_PREP(raw, Lb) do { const f32x4 r_ = bf4((raw).r), k_ = bf4((raw).k), ew_ = bf4((raw).e), aa_ = bf4((raw).av); f32x4 v_ = bf4((raw).v); \
        if (j == 1) { const f32x4 vf_ = bf4((raw).f), vg_ = bf4((raw).vg); v_ = v_ + (vf_ - v_) * vg_; } \
        f32x4 kk_ = k_ * kk4; float n2_ = (kk_[0] * kk_[0] + kk_[1] * kk_[1]) + (kk_[2] * kk_[2] + kk_[3] * kk_[3]); n2_ = red16(n2_); \
        kk_ = kk_ * (1.0f / fmaxf(sqrtf(n2_), 1e-12f)); const f32x4 km_ = k_ * (1.0f + (aa_ - 1.0f) * ka4); \
        f32x4 w_; w_[0] = expf_(-ew_[0]); w_[1] = expf_(-ew_[1]); w_[2] = expf_(-ew_[2]); w_[3] = expf_(-ew_[3]); \
        float bon_ = (r_[0] * km_[0] * rk4[0] + r_[1] * km_[1] * rk4[1]) + (r_[2] * km_[2] * rk4[2] + r_[3] * km_[3] * rk4[3]); bon_ = red16(bon_); \
        const int li_ = pt * 64 + pc; *(LAS f32x4*)((Lb) + li_) = r_; *(LAS f32x4*)((Lb) + ARR + li_) = w_; *(LAS f32x4*)((Lb) + 2 * ARR + li_) = km_; *(LAS f32x4*)((Lb) + 3 * ARR + li_) = v_; \
        *(LAS f32x4*)((Lb) + 4 * ARR + li_) = -kk_; *(LAS f32x4*)((Lb) + 5 * ARR + li_) = kk_ * aa_; *(LAS f32x4*)((Lb) + 6 * ARR + li_) = bf4((raw).g); if ((tid & 15) == 0) (Lb)[7 * ARR + pt] = bon_; } while (0)
    ScanRaw raw; raw.f = (u32x2){0u, 0u}; raw.vg = raw.f;
    SCAN_FETCH(raw, 0); SCAN_PREP(raw, L0);
    __syncthreads();
    f32x2 S0a = {0.f, 0.f}, S0b = S0a, S1a = S0a, S1b = S0a;
    for (int c = 0; c < SEQ / TC; ++c) {
        LAS float* Lc = L0 + (c & 1) * BUFW; LAS float* Ln = L0 + ((c + 1) & 1) * BUFW;
        const bool more = (c + 1) < SEQ / TC;
        if (more) SCAN_FETCH(raw, (c + 1) * TC);
        {
            f32x4 rr = *(const LAS f32x4*)(Lc + sq), ww = *(const LAS f32x4*)(Lc + ARR + sq), kx = *(const LAS f32x4*)(Lc + 2 * ARR + sq), an = *(const LAS f32x4*)(Lc + 4 * ARR + sq), bb = *(const LAS f32x4*)(Lc + 5 * ARR + sq);
            float v0 = Lc[3 * ARR + sp], v1 = Lc[3 * ARR + sp + 32];
            for (int tb = 0; tb < TC / 16; ++tb) { float yk0 = 0.f, yk1 = 0.f;
#pragma unroll
                for (int ti = 0; ti < 16; ++ti) { const int t = tb * 16 + ti; const int tn = (t + 1 < TC) ? t + 1 : t; const int lo = tn * 64 + sq;
                    const f32x4 rr_n = *(const LAS f32x4*)(Lc + lo), ww_n = *(const LAS f32x4*)(Lc + ARR + lo), kx_n = *(const LAS f32x4*)(Lc + 2 * ARR + lo), an_n = *(const LAS f32x4*)(Lc + 4 * ARR + lo), bb_n = *(const LAS f32x4*)(Lc + 5 * ARR + lo);
                    const float v0_n = Lc[3 * ARR + tn * 64 + sp], v1_n = Lc[3 * ARR + tn * 64 + sp + 32];
                    const f32x2 an0 = {an[0], an[1]}, an1 = {an[2], an[3]}, w0 = {ww[0], ww[1]}, w1 = {ww[2], ww[3]}, k0 = {kx[0], kx[1]}, k1 = {kx[2], kx[3]}, b0 = {bb[0], bb[1]}, b1 = {bb[2], bb[3]}, r0 = {rr[0], rr[1]}, r1 = {rr[2], rr[3]};
                    const f32x2 p0 = S0a * an0 + S0b * an1, p1 = S1a * an0 + S1b * an1;
                    const float sa0 = red16(p0.x + p0.y), sa1 = red16(p1.x + p1.y);
                    const f32x2 sa0v = {sa0, sa0}, sa1v = {sa1, sa1}, v0v = {v0, v0}, v1v = {v1, v1};
                    S0a = S0a * w0 + (v0v * k0 + sa0v * b0); S0b = S0b * w1 + (v0v * k1 + sa0v * b1);
                    S1a = S1a * w0 + (v1v * k0 + sa1v * b0); S1b = S1b * w1 + (v1v * k1 + sa1v * b1);
                    const f32x2 q0 = S0a * r0 + S0b * r1, q1 = S1a * r0 + S1b * r1;
                    const float y0 = red16(q0.x + q0.y), y1 = red16(q1.x + q1.y);
                    const bool mine = (tid & 15) == ti; yk0 = mine ? y0 : yk0; yk1 = mine ? y1 : yk1;
                    rr = rr_n; ww = ww_n; kx = kx_n; an = an_n; bb = bb_n; v0 = v0_n; v1 = v1_n; }
                L_y[(tb * 16 + (tid & 15)) * 64 + sp] = yk0; L_y[(tb * 16 + (tid & 15)) * 64 + sp + 32] = yk1; }
        }
        __syncthreads();
        {
            const int li = pt * 64 + pc; const f32x4 y = *(const LAS f32x4*)(L_y + li), v = *(const LAS f32x4*)(Lc + 3 * ARR + li), gg = *(const LAS f32x4*)(Lc + 6 * ARR + li);
            float s1 = (y[0] + y[1]) + (y[2] + y[3]); s1 = red16(s1); const float mu = s1 * (1.0f / 64.0f);
            const f32x4 d = y - mu; float q = (d[0] * d[0] + d[1] * d[1]) + (d[2] * d[2] + d[3] * d[3]); q = red16(q);
            const float rs = __builtin_amdgcn_rsqf(q * (1.0f / 64.0f) + GN_EPS); const float bon = Lc[7 * ARR + pt];
            const f32x4 o = (d * rs * gg4 + gb4 + bon * v) * gg;
            u32x2 wv2; wv2.x = cvt_pk_bf16(o[0], o[1]); wv2.y = cvt_pk_bf16(o[2], o[3]); *(u32x2*)(Y + grow0 + (size_t)(c * TC) * D) = wv2;
        }
        if (more) SCAN_PREP(raw, Ln);
        __syncthreads();
    }
#undef SCAN_FETCH
#undef SCAN_PREP
}
#undef a
typedef __attribute__((address_space(1))) unsigned long long gu64_t;
__device__ __forceinline__ void rwkv_scan_split(LAS unsigned char* lds, int head, int half, int j, int wv, int cv_lo, int cv_hi) {
    KArgs ap = kargs();
#define a (*ap)
    asm volatile("" : "+s"(wv)); const int lane = lane_id(); const int tid = wv * 64 + lane;
    unsigned char* ws = a.ws;
    const int hd = head & 31, b = head >> 5; const int cbase = hd * 64, own = 32 * half;
    constexpr int NCH = SEQ / TC;
    LAS float* OPB = (LAS float*)lds; LAS float* VB = OPB + 2 * 5 * 2048; LAS float* FG = VB + 4 * 1024; LAS float* YB = FG + 4 * 1024; LAS float* FB = YB + 3 * 1024; LAS float* ST = FB + 4 * 32;
    gu64_t* XG = (gu64_t*)(ws + WS_XG); gu64_t* xg_mine = XG + (size_t)((head * 2 + half) * NCH) * 64; gu64_t* xg_peer = XG + (size_t)((head * 2 + (half ^ 1)) * NCH) * 64;
    const bool is_s = wv < 4; const int ht = tid - 256; const int hgw = (head * 2 + half) * 4 + (wv - 4);
    const int tagbase = (j + 1) << 10;
    const int pt = (ht >> 3) & 31, c8 = (ht & 7) * 8;
    const int r4 = (ht & 7) * 4;
    const size_t grow0 = (size_t)(b * SEQ + pt) * D + cbase + c8;
    const bf16_t* Rb = (const bf16_t*)(ws + WS_RKV); const bf16_t* Kb = Rb + (size_t)M * D; const bf16_t* Vb = j == 0 ? (const bf16_t*)(ws + WS_VF) : Rb + (size_t)2 * M * D; const bf16_t* VF = (const bf16_t*)(ws + WS_VF);
    const bf16_t* EW = (const bf16_t*)(ws + WS_WAGV); const bf16_t* Ab = EW + (size_t)M * D; const bf16_t* Gb = EW + (size_t)2 * M * D; const bf16_t* VG = EW + (size_t)3 * M * D;
    bf16_t* Y = (bf16_t*)(ws + WS_Y);
    u32x4 rw_r, rw_k, rw_v, rw_e, rw_a, rw_g, rw_f, rw_vg; rw_f = (u32x4){0u, 0u, 0u, 0u}; rw_vg = rw_f; rw_r = rw_f; rw_k = rw_f; rw_v = rw_f; rw_e = rw_f; rw_a = rw_f; rw_g = rw_f;
#define SP_FETCH(cn) do { const size_t gr_ = grow0 + (size_t)((cn) * TC) * D; rw_r = *(const u32x4*)(Rb + gr_); rw_k = *(const u32x4*)(Kb + gr_); rw_v = *(const u32x4*)(Vb + gr_); rw_e = *(const u32x4*)(EW + gr_); \
        rw_a = *(const u32x4*)(Ab + gr_); rw_g = *(const u32x4*)(Gb + gr_); if (j == 1) { rw_f = *(const u32x4*)(VF + gr_); rw_vg = *(const u32x4*)(VG + gr_); } } while (0)
#define SP_PREP(cn) do { f32x4 r0_, r1_, k0_, k1_, v0_, v1_, e0_, e1_, a0_, a1_, g0_, g1_; pg8::unpack8(rw_r, r0_, r1_); pg8::unpack8(rw_k, k0_, k1_); pg8::unpack8(rw_v, v0_, v1_); pg8::unpack8(rw_e, e0_, e1_); pg8::unpack8(rw_a, a0_, a1_); pg8::unpack8(rw_g, g0_, g1_); \
        if (j == 1) { f32x4 f0_, f1_, m0_, m1_; pg8::unpack8(rw_f, f0_, f1_); pg8::unpack8(rw_vg, m0_, m1_); v0_ = v0_ + (f0_ - v0_) * m0_; v1_ = v1_ + (f1_ - v1_) * m1_; } \
        const f32x4 kkw0_ = *(const f32x4*)(a.in[I_CKK] + (size_t)j * D + cbase + c8), kkw1_ = *(const f32x4*)(a.in[I_CKK] + (size_t)j * D + cbase + c8 + 4), kaw0_ = *(const f32x4*)(a.in[I_CKA] + (size_t)j * D + cbase + c8), kaw1_ = *(const f32x4*)(a.in[I_CKA] + (size_t)j * D + cbase + c8 + 4); \
        const f32x4 rkw0_ = *(const f32x4*)(a.in[I_CRK] + (size_t)j * D + cbase + c8), rkw1_ = *(const f32x4*)(a.in[I_CRK] + (size_t)j * D + cbase + c8 + 4); \
        f32x4 q0_ = k0_ * kkw0_, q1_ = k1_ * kkw1_; float n2_ = (q0_[0] * q0_[0] + q0_[1] * q0_[1]) + (q0_[2] * q0_[2] + q0_[3] * q0_[3]) + (q1_[0] * q1_[0] + q1_[1] * q1_[1]) + (q1_[2] * q1_[2] + q1_[3] * q1_[3]); n2_ = red8(n2_); \
        const float inv_ = 1.0f / fmaxf(sqrtf(n2_), 1e-12f); q0_ = q0_ * inv_; q1_ = q1_ * inv_; const f32x4 km0_ = k0_ * (1.0f + (a0_ - 1.0f) * kaw0_), km1_ = k1_ * (1.0f + (a1_ - 1.0f) * kaw1_); \
        f32x4 w0_, w1_; for (int e_ = 0; e_ < 4; ++e_) { w0_[e_] = expf_(-e0_[e_]); w1_[e_] = expf_(-e1_[e_]); } \
        float bon_ = (r0_[0] * km0_[0] * rkw0_[0] + r0_[1] * km0_[1] * rkw0_[1]) + (r0_[2] * km0_[2] * rkw0_[2] + r0_[3] * km0_[3] * rkw0_[3]) + (r1_[0] * km1_[0] * rkw1_[0] + r1_[1] * km1_[1] * rkw1_[1]) + (r1_[2] * km1_[2] * rkw1_[2] + r1_[3] * km1_[3] * rkw1_[3]); bon_ = red8(bon_); \
        LAS float* ob_ = OPB + ((cn) & 1) * 10240 + pt * 64 + c8; *(LAS f32x4*)(ob_) = r0_; *(LAS f32x4*)(ob_ + 4) = r1_; *(LAS f32x4*)(ob_ + 2048) = w0_; *(LAS f32x4*)(ob_ + 2052) = w1_; *(LAS f32x4*)(ob_ + 4096) = km0_; *(LAS f32x4*)(ob_ + 4100) = km1_; \
        *(LAS f32x4*)(ob_ + 6144) = -q0_; *(LAS f32x4*)(ob_ + 6148) = -q1_; *(LAS f32x4*)(ob_ + 8192) = q0_ * a0_; *(LAS f32x4*)(ob_ + 8196) = q1_ * a1_; \
        if ((c8 >> 5) == half) { const int o_ = ((cn) & 3) * 1024 + pt * 32 + (c8 & 31); *(LAS f32x4*)(VB + o_) = v0_; *(LAS f32x4*)(VB + o_ + 4) = v1_; *(LAS f32x4*)(FG + o_) = g0_; *(LAS f32x4*)(FG + o_ + 4) = g1_; } \
        if ((ht & 7) == 0) FB[((cn) & 3) * 32 + pt] = bon_; } while (0)
    if (!is_s) { SP_FETCH(0); SP_PREP(0); }
    __syncthreads();
    const int sp = (tid >> 4) & 15, sq = (tid & 15) * 4;
    f32x2 S0a = {0.f, 0.f}, S0b = S0a, S1a = S0a, S1b = S0a;
    const int cv_per = (cv_hi - cv_lo + 1023) / 1024; int cv_it = cv_lo + hgw * cv_per; const int cv_end = (cv_it + cv_per < cv_hi) ? cv_it + cv_per : cv_hi; bool cv_on = !is_s && cv_it < cv_end;
    TrDesc cvd; f32x4 cvx[2][4]; f32x4 cvx1[1][4];
    if (cv_on) { cvd = tr_decode(cv_it); if (cvd.nc == 2) tr_load<2>(cvd.W, cvd.N, cvd.k0, cvd.n0, cvx, lane); else tr_load<1>(cvd.W, cvd.N, cvd.k0, cvd.n0, cvx1, lane); }
    if (is_s) __builtin_amdgcn_s_setprio(2);
    for (int c = 0; c < NCH + 2; ++c) {
        if (is_s) {
            if (c < NCH) {
                LAS float* Lc = OPB + (c & 1) * 10240; LAS float* Lv = VB + (c & 3) * 1024; LAS float* Ly = YB + (c % 3) * 1024;
                f32x4 rr = *(const LAS f32x4*)(Lc + sq), ww = *(const LAS f32x4*)(Lc + 2048 + sq), kx = *(const LAS f32x4*)(Lc + 4096 + sq), an = *(const LAS f32x4*)(Lc + 6144 + sq), bb = *(const LAS f32x4*)(Lc + 8192 + sq);
                float v0 = Lv[sp], v1 = Lv[sp + 16];
                for (int tb = 0; tb < TC / 16; ++tb) { float py0[16], py1[16];
#pragma unroll
                    for (int ti = 0; ti < 16; ++ti) { const int t = tb * 16 + ti; const int tn = (t + 1 < TC) ? t + 1 : t; const int lo = tn * 64 + sq;
                        const f32x4 rr_n = *(const LAS f32x4*)(Lc + lo), ww_n = *(const LAS f32x4*)(Lc + 2048 + lo), kx_n = *(const LAS f32x4*)(Lc + 4096 + lo), an_n = *(const LAS f32x4*)(Lc + 6144 + lo), bb_n = *(const LAS f32x4*)(Lc + 8192 + lo);
                        const float v0_n = Lv[tn * 32 + sp], v1_n = Lv[tn * 32 + sp + 16];
                        const f32x2 an0 = {an[0], an[1]}, an1 = {an[2], an[3]}, w0 = {ww[0], ww[1]}, w1 = {ww[2], ww[3]}, k0 = {kx[0], kx[1]}, k1 = {kx[2], kx[3]}, b0 = {bb[0], bb[1]}, b1 = {bb[2], bb[3]}, r0 = {rr[0], rr[1]}, r1 = {rr[2], rr[3]};
                        const f32x2 p0 = S0a * an0 + S0b * an1, p1 = S1a * an0 + S1b * an1;
                        const float sa0 = red16(p0.x + p0.y), sa1 = red16(p1.x + p1.y);
                        const f32x2 sa0v = {sa0, sa0}, sa1v = {sa1, sa1}, v0v = {v0, v0}, v1v = {v1, v1};
                        S0a = S0a * w0 + (v0v * k0 + sa0v * b0); S0b = S0b * w1 + (v0v * k1 + sa0v * b1);
                        S1a = S1a * w0 + (v1v * k0 + sa1v * b0); S1b = S1b * w1 + (v1v * k1 + sa1v * b1);
                        const f32x2 q0 = S0a * r0 + S0b * r1, q1 = S1a * r0 + S1b * r1;
                        py0[ti] = q0.x + q0.y; py1[ti] = q1.x + q1.y;
                        rr = rr_n; ww = ww_n; kx = kx_n; an = an_n; bb = bb_n; v0 = v0_n; v1 = v1_n; }
                    const bool b8 = (tid & 8) != 0, b4 = (tid & 4) != 0, b2 = (tid & 2) != 0, b1 = (tid & 1) != 0;
                    const float yk0 = tred16(py0, b8, b4, b2, b1), yk1 = tred16(py1, b8, b4, b2, b1);
                    Ly[(tb * 16 + (tid & 15)) * 32 + sp] = yk0; Ly[(tb * 16 + (tid & 15)) * 32 + sp + 16] = yk1; }
            }
        } else {

            unsigned long long xgv = 0ull; if (c >= 2) xgv = __hip_atomic_load(xg_peer + (size_t)(c - 2) * 64 + lane, __ATOMIC_RELAXED, __HIP_MEMORY_SCOPE_AGENT);
            if (c + 1 < NCH) SP_FETCH(c + 1);
            float st1 = 0.f, st2 = 0.f;
            if (c >= 1 && c <= NCH) { const f32x4 y = *(const LAS f32x4*)(YB + ((c - 1) % 3) * 1024 + pt * 32 + r4);
                st1 = (y[0] + y[1]) + (y[2] + y[3]); st2 = (y[0] * y[0] + y[1] * y[1]) + (y[2] * y[2] + y[3] * y[3]); st1 = red8(st1); st2 = red8(st2);
                if ((ht & 7) == 0) { ST[((c - 1) & 3) * 64 + pt] = st1; ST[((c - 1) & 3) * 64 + 32 + pt] = st2; } }
            if (c >= 2) { const int cf = c - 2; gu64_t* g = xg_peer + (size_t)cf * 64; unsigned long long x = xgv; unsigned spins = 0;
                while (!__all((unsigned)(x >> 32) == (unsigned)(tagbase + cf + 1))) { if (++spins > (1u << 22)) break; __builtin_amdgcn_s_sleep(1); x = __hip_atomic_load(g + lane, __ATOMIC_RELAXED, __HIP_MEMORY_SCOPE_AGENT); }
                const float pv = __uint_as_float((unsigned)x); const int tl = (lane >> 3) + 8 * (wv - 4);
                const float s1p = __int_as_float(__builtin_amdgcn_ds_bpermute(tl << 2, __float_as_int(pv))), s2p = __int_as_float(__builtin_amdgcn_ds_bpermute((32 + tl) << 2, __float_as_int(pv)));
                const float s1 = ST[(cf & 3) * 64 + pt] + s1p, s2 = ST[(cf & 3) * 64 + 32 + pt] + s2p; const float mu = s1 * (1.0f / 64.0f); const float var = fmaxf(s2 * (1.0f / 64.0f) - mu * mu, 0.f);
                const float rs = __builtin_amdgcn_rsqf(var + GN_EPS); const float bon = FB[(cf & 3) * 32 + pt];
                const f32x4 y = *(const LAS f32x4*)(YB + (cf % 3) * 1024 + pt * 32 + r4), v = *(const LAS f32x4*)(VB + (cf & 3) * 1024 + pt * 32 + r4), gg = *(const LAS f32x4*)(FG + (cf & 3) * 1024 + pt * 32 + r4);
                const f32x4 gn_g = *(const f32x4*)(a.in[I_CGNG] + (size_t)j * D + cbase + own + r4), gn_b = *(const f32x4*)(a.in[I_CGNB] + (size_t)j * D + cbase + own + r4);
                const f32x4 o = ((y - mu) * rs * gn_g + gn_b + bon * v) * gg;
                u32x2 w2; w2.x = cvt_pk_bf16(o[0], o[1]); w2.y = cvt_pk_bf16(o[2], o[3]); *(u32x2*)(Y + (size_t)(b * SEQ + cf * TC + pt) * D + cbase + own + r4) = w2; }
            if (cv_on) { if (cvd.nc == 2) tr_finish<2>(cvd.WT, cvd.ldk, cvd.k0, cvd.drow, cvd.gain, cvx, lane); else tr_finish<1>(cvd.WT, cvd.ldk, cvd.k0, cvd.drow, cvd.gain, cvx1, lane); }
            if (c + 1 < NCH) SP_PREP(c + 1);
            if (c >= 1 && c <= NCH && (ht & 7) == 0) { gu64_t* g = xg_mine + (size_t)(c - 1) * 64;
                __hip_atomic_store(g + pt, ((unsigned long long)(unsigned)(tagbase + c) << 32) | __float_as_uint(st1), __ATOMIC_RELAXED, __HIP_MEMORY_SCOPE_AGENT);
                __hip_atomic_store(g + 32 + pt, ((unsigned long long)(unsigned)(tagbase + c) << 32) | __float_as_uint(st2), __ATOMIC_RELAXED, __HIP_MEMORY_SCOPE_AGENT); }
            if (cv_on) { ++cv_it; cv_on = cv_it < cv_end; if (cv_on) { tr_next(cvd, cv_it); if (cvd.nc == 2) tr_load<2>(cvd.W, cvd.N, cvd.k0, cvd.n0, cvx, lane); else tr_load<1>(cvd.W, cvd.N, cvd.k0, cvd.n0, cvx1, lane); } }
        }
        __syncthreads();
    }
    if (is_s) __builtin_amdgcn_s_setprio(0);
    while (cv_on) {
        if (cvd.nc == 2) tr_finish<2>(cvd.WT, cvd.ldk, cvd.k0, cvd.drow, cvd.gain, cvx, lane); else tr_finish<1>(cvd.WT, cvd.ldk, cvd.k0, cvd.drow, cvd.gain, cvx1, lane);
        ++cv_it; cv_on = cv_it < cv_end; if (cv_on) { tr_next(cvd, cv_it); if (cvd.nc == 2) tr_load<2>(cvd.W, cvd.N, cvd.k0, cvd.n0, cvx, lane); else tr_load<1>(cvd.W, cvd.N, cvd.k0, cvd.n0, cvx1, lane); } }
#undef SP_FETCH
#undef SP_PREP
}
#undef a

__device__ __forceinline__ void final_norm(int G, int wv) {
    KArgs ap = kargs();
#define a (*ap)
    asm volatile("" : "+s"(wv)); int tid = TID_FROM_WAVE(wv);
    const int lane = tid & 63, wave = wv;
    const bf16_t* hi = (const bf16_t*)(a.ws + WS_HB1); const unsigned char* lo = a.ws + WS_H; const float* ss = (const float*)(a.ws + WS_SS) + (size_t)16 * M; const float* gn = a.in[I_FNORM];
    int bid = blockIdx.x; asm volatile("" : "+s"(bid), "+s"(G)); const int gw = bid * NWAVES + wave, NGW = G * NWAVES;
    for (int row = gw; row < M; row += NGW) { const float rs = rstd_of(ss[row]);
#pragma unroll
        for (int q = 0; q < 8; ++q) { const int c = (q * 64 + lane) * 4; *(f32x4*)(a.out + (size_t)row * D + c) = hl4(*(const u32x2*)(hi + (size_t)row * D + c), *(const unsigned*)(lo + (size_t)row * D + c)) * rs * *(const f32x4*)(gn + c); } }
}

#undef a
constexpr int PH_PER_LAYER = 10, N_PHASES = 2 + DEPTH * PH_PER_LAYER;
#define IN(k) (kargs()->ph_lo <= (k) && (k) < kargs()->ph_hi)
#define SEAM(k) do { if (IN(k) && IN((k) + 1)) { XcdBarrier bar_; bar_.bar = (unsigned*)(kargs()->ws + WS_CTL) + CW_BAR; bar_.x = xb_xcc_id(); bar_.st = (volatile LAS unsigned*)(lds + MISC_OFF) + 8; xcd_barrier(bar_, wv); } } while (0)
#define SITE KArgs ap = kargs(); unsigned char* ws = ap->ws; int G = gridDim.x, bid = blockIdx.x; asm volatile("" : "+s"(G), "+s"(bid)); float* SSb = (float*)(ws + WS_SS); unsigned char* HL = ws + WS_H; bf16_t* HB0 = (bf16_t*)(ws + WS_HB0); bf16_t* HB1 = (bf16_t*)(ws + WS_HB1); bf16_t* HF = (bf16_t*)(ws + WS_HF); \
             (void)SSb; (void)HL; (void)HB0; (void)HB1; (void)HF

#define IDLE_CONVERT(slot) do { if ((slot) >= 0) { int G_ = gridDim.x, bid_ = blockIdx.x; asm volatile("" : "+s"(G_), "+s"(bid_)); const int first_ = G_ > 128 ? 128 : 0; \
    if (bid_ >= first_) convert_items(CV_A + ((slot) > 0 ? cvq_end((slot) > 0 ? (slot) - 1 : 0) : 0), CV_A + cvq_end((slot) >= 0 ? (slot) : 0), (bid_ - first_) * NWAVES + wv, (G_ - first_) * NWAVES, lane_id()); } } while (0)
template <int L> __device__ __forceinline__ void layer_phases(LAS unsigned char* lds, int wv) {
        constexpr int SLOT_GU1 = L == 0 ? 0 : (L == 1 ? 2 : (L == 2 ? 5 : 7)), SLOT_GU2 = L == 0 ? 1 : (L == 1 ? 4 : (L == 2 ? 6 : 9)), SLOT_SCAN = L == 1 ? 3 : (L == 3 ? 8 : -1);
        constexpr int base = 1 + L * PH_PER_LAYER, j = L >> 1;
        if (IN(base + 0)) { SITE; pg8::GemmPlain<D, D, D> g{HB1, (const bf16_t*)(ws + WS_WGU) + (size_t)(2 * L) * 2 * FF * D}; pg8::StaticOrder S; S.init(M, 2 * FF, G, bid);
            pg8::EpiGU E{HF, SSb + (size_t)(4 * L + 0) * M}; pg8::gemm_phase(lds, g, S, E, wv); IDLE_CONVERT(SLOT_GU1); }
        SEAM(base + 0);
        if (IN(base + 1)) { SITE; pg8::GemmPlain<FF, FF, FF> g{HF, (const bf16_t*)(ws + WS_WD) + (size_t)(2 * L) * D * FF}; pg8::StaticOrder S; S.init(M, D, G, bid);
            pg8::EpiResid E{HB1, HB0, HL, SSb + (size_t)(4 * L + 1) * M, 0.5f}; pg8::gemm_phase(lds, g, S, E, wv); }
        SEAM(base + 1);
        if ((L & 1) == 0) {
            if (IN(base + 2)) { SITE; pg8::GemmPlain<D, D, D> g{HB0, (const bf16_t*)(ws + WS_WEIN) + (size_t)j * EIN * D}; pg8::StaticOrder S; S.init(M, EIN, G, bid);
                pg8::EpiEvenIn E{(bf16_t*)(ws + WS_EA), (float*)(ws + WS_LOGF), SSb + (size_t)(4 * L + 1) * M, (const float*)(ws + WS_LB) + (size_t)L * 1024};
                pg8::gemm_phase(lds, g, S, E, wv); }
            SEAM(base + 2);
            if (IN(base + 3)) { int G = gridDim.x, bid = blockIdx.x; asm volatile("" : "+s"(G), "+s"(bid)); { int gp = -1; for (int u = bid; u < 512; u += G) { gmlp_unit(lds, u, j, wv, (u & 7) == gp); gp = u & 7; } } hgrn_p1_all(lds, wv); }
            SEAM(base + 3);
            if (IN(base + 4)) hgrn_p2(gridDim.x, wv);
            SEAM(base + 4);
            if (IN(base + 5)) hgrn_p3_all(lds, j, wv);
            SEAM(base + 5);
            if (IN(base + 6)) { SITE; pg8::GemmPlain<D, D, D> g{(const bf16_t*)(ws + WS_AB), (const bf16_t*)(ws + WS_WEOUT) + (size_t)j * D * D}; pg8::StaticOrder S; S.init(M, D, G, bid);
                pg8::EpiResid E{HB0, HB0, HL, SSb + (size_t)(4 * L + 2) * M, 1.0f}; pg8::gemm_phase(lds, g, S, E, wv); }
            SEAM(base + 6);
        } else {
            if (IN(base + 2)) rwkv_mix(gridDim.x, L, j, wv);
            SEAM(base + 2);
            if (IN(base + 3)) { SITE; pg8::GemmRwkvIn g{(const bf16_t*)(ws + WS_XM), (const bf16_t*)(ws + WS_WRIN) + (size_t)j * RIN_N * D}; pg8::StaticOrder S; S.init(M, j == 1 ? RIN_N : RIN_N - 256, G, bid);
                pg8::EpiRwkvIn E{ws, j}; pg8::gemm_phase(lds, g, S, E, wv); }
            SEAM(base + 3);
            if (IN(base + 4)) { SITE; pg8::GemmLoraOut g{(const bf16_t*)(ws + WS_T), (const bf16_t*)(ws + WS_WL2) + (size_t)j * 8192 * 256}; pg8::StaticOrder S; S.init(M, j == 1 ? 8192 : 6144, G, bid);
                pg8::EpiLoraOut E{(bf16_t*)(ws + WS_WAGV), (const float*)(ws + WS_LBIAS) + (size_t)j * 4 * D};
                pg8::gemm_phase(lds, g, S, E, wv); }
            SEAM(base + 4);
            if (IN(base + 5)) { int G = gridDim.x, bid = blockIdx.x; asm volatile("" : "+s"(G), "+s"(bid)); if (G == 256) { rwkv_scan_split(lds, bid >> 1, bid & 1, j, wv, SLOT_SCAN >= 0 ? CV_A + cvq_end(SLOT_SCAN > 0 ? SLOT_SCAN - 1 : 0) : 0, SLOT_SCAN >= 0 ? CV_A + cvq_end(SLOT_SCAN >= 0 ? SLOT_SCAN : 0) : 0); } else { for (int u = bid; u < 128; u += G) rwkv_scan_unit(lds, u, j, wv); IDLE_CONVERT(SLOT_SCAN); } }
            SEAM(base + 5);
            if (IN(base + 6)) { SITE; pg8::GemmPlain<D, D, D> g{(const bf16_t*)(ws + WS_Y), (const bf16_t*)(ws + WS_WO) + (size_t)j * D * D}; pg8::StaticOrder S; S.init(M, D, G, bid);
                pg8::EpiResid E{HB0, HB0, HL, SSb + (size_t)(4 * L + 2) * M, 1.0f}; pg8::gemm_phase(lds, g, S, E, wv); }
            SEAM(base + 6);
        }
        if (IN(base + 7)) { SITE; pg8::GemmPlain<D, D, D> g{HB0, (const bf16_t*)(ws + WS_WGU) + (size_t)(2 * L + 1) * 2 * FF * D}; pg8::StaticOrder S; S.init(M, 2 * FF, G, bid);
            pg8::EpiGU E{HF, SSb + (size_t)(4 * L + 2) * M}; pg8::gemm_phase(lds, g, S, E, wv);
            if (G == 256 && bid >= 128) { pg8::GemmPlain<PLE, PLE, PLE> g2{(const bf16_t*)(ws + WS_PB) + (size_t)L * M * PLE, (const bf16_t*)(ws + WS_WPP) + (size_t)L * D * PLE}; pg8::StaticOrder S2; S2.init(M, D, 128, bid - 128);
              pg8::EpiStore E2{(bf16_t*)(ws + WS_PW), D}; pg8::gemm_phase(lds, g2, S2, E2, wv); }
            IDLE_CONVERT(SLOT_GU2); }
        SEAM(base + 7);
        if (IN(base + 8)) {
            { SITE; pg8::GemmPlain<FF, FF, FF> g{HF, (const bf16_t*)(ws + WS_WD) + (size_t)(2 * L + 1) * D * FF}; pg8::StaticOrder S; S.init(M, D, G, bid);
              pg8::EpiResid E{HB0, HB0, HL, SSb + (size_t)(4 * L + 3) * M, 0.5f}; pg8::gemm_phase(lds, g, S, E, wv); }
            if (gridDim.x != 256) { SITE; pg8::GemmPlain<PLE, PLE, PLE> g{(const bf16_t*)(ws + WS_PB) + (size_t)L * M * PLE, (const bf16_t*)(ws + WS_WPP) + (size_t)L * D * PLE}; pg8::StaticOrder S; S.init(M, D, G, bid);
              pg8::EpiStore E{(bf16_t*)(ws + WS_PW), D}; pg8::gemm_phase(lds, g, S, E, wv); }
        }
        SEAM(base + 8);
        if (IN(base + 9)) { SITE; pg8::GemmPlain<D, D, D> g{HB0, (const bf16_t*)(ws + WS_WPG) + (size_t)L * D * D}; pg8::StaticOrder S; S.init(M, D, G, bid);
            pg8::EpiPLE E{HB0, HB1, HL, SSb + (size_t)(4 * L + 4) * M, SSb + (size_t)(4 * L + 3) * M, (const bf16_t*)(ws + WS_PW)}; pg8::gemm_phase(lds, g, S, E, wv); }
        SEAM(base + 9);
}

__global__ void __launch_bounds__(NTHR, 2) mega(Args a_unused) {
    extern __shared__ __attribute__((aligned(16))) unsigned char lds_raw[];
    LAS unsigned char* lds = (LAS unsigned char*)lds_raw;
    const int wv = __builtin_amdgcn_readfirstlane((int)threadIdx.x >> 6);
    if (threadIdx.x < 32) ((volatile LAS unsigned*)(lds + MISC_OFF))[threadIdx.x] = 0u;
    __syncthreads();
    { KArgs ap = kargs(); if (ap->use_bar) (void)xcd_barrier_post((unsigned*)(ap->ws + WS_CTL) + CW_BAR, (volatile LAS unsigned*)(lds + MISC_OFF) + 8); }
    if (IN(0)) prologue(lds, gridDim.x, wv);
    SEAM(0);

    layer_phases<0>(lds, wv); layer_phases<1>(lds, wv); layer_phases<2>(lds, wv); layer_phases<3>(lds, wv);
    if (IN(N_PHASES - 1)) final_norm(gridDim.x, wv);
#undef IN
#undef SEAM
#undef SITE
#undef IDLE_CONVERT
}

extern "C" void kernel_launch(void* const* d_in, const int* in_sizes, int n_in, void* d_out, int out_size, void* d_ws, size_t ws_size, hipStream_t stream) {
    static int grid = 0;
    if (grid == 0) {
        if (n_in != 37 || out_size != M * D || ws_size < WS_END) { fprintf(stderr, "kernel_launch: unexpected problem (n_in %d, out %d, ws %zu < %zu)\n", n_in, out_size, ws_size, (size_t)WS_END); grid = -1; return; }
        int dev = 0, cus = 0, per_cu = 0;
        if (hipGetDevice(&dev) != hipSuccess || hipDeviceGetAttribute(&cus, hipDeviceAttributeMultiprocessorCount, dev) != hipSuccess) { grid = -1; return; }
        if (hipFuncSetAttribute((const void*)mega, hipFuncAttributeMaxDynamicSharedMemorySize, LDS_BYTES) != hipSuccess) { fprintf(stderr, "kernel_launch: hipFuncSetAttribute failed\n"); grid = -1; return; }
        if (hipOccupancyMaxActiveBlocksPerMultiprocessor(&per_cu, (const void*)mega, NTHR, LDS_BYTES) != hipSuccess || per_cu < 1) fprintf(stderr, "kernel_launch: occupancy query says %d\n", per_cu);
        (void)hipGetLastError();
        grid = cus;
    }
    if (grid < 0) return;
    (void)hipMemsetAsync((char*)d_ws + WS_CTL, 0, CTL_ZERO_BYTES, stream);
    Args a{};
    for (int i = 0; i < 37; ++i) a.in[i] = (const float*)d_in[i];
    a.out = (float*)d_out; a.ws = (unsigned char*)d_ws; a.pad = 0;
#if N_LAUNCH_MODE == 0
    a.ph_lo = 0; a.ph_hi = N_PHASES; a.use_bar = 1;
    hipLaunchKernelGGL(mega, dim3(grid), dim3(NTHR), LDS_BYTES, stream, a);
#else
    a.use_bar = 0;
    for (int p = 0; p < N_PHASES; ++p) { a.ph_lo = p; a.ph_hi = p + 1; hipLaunchKernelGGL(mega, dim3(grid), dim3(NTHR), LDS_BYTES, stream, a); }
#endif
}
```
